# Optimizing an MI355X kernel written in HIP

```python
import math
import jax, jax.numpy as jnp
from jax import lax
import numpy as np

D_MODEL = 1024
BATCH = 8
SEQ = 2048
DEPTH = 1

D_MIX = D_MODEL
A_WIDTH = D_MIX // 2
B_WIDTH = D_MIX - A_WIDTH
A_HEADS = 4
A_HEAD_DIM = A_WIDTH // A_HEADS
CHUNK = 128
B_HEADS = 4
B_HEAD_DIM = B_WIDTH // (2 * B_HEADS)
B_V_DIM = 2 * B_HEAD_DIM
Q_BLOCK = 128
ROPE_THETA = 10000.0
NORM_EPS = 1e-6
SUBLN_EPS = 1e-5
IN_COLS = 3 * A_WIDTH + 4 * B_WIDTH

kernel_name = "hybrid_gmlp_diffattn_adaln_layer"


def rms_norm(x, w, eps):
    xf = x.astype(jnp.float32)
    y = xf * lax.rsqrt(jnp.mean(xf * xf, axis=-1, keepdims=True) + eps)
    return (y * w.astype(jnp.float32)).astype(x.dtype)


def apply_rope(t, positions):
    d = t.shape[-1]
    inv_freq = ROPE_THETA ** (-jnp.arange(0, d, 2, dtype=jnp.float32) / d)
    ang = positions.astype(jnp.float32)[..., None] * inv_freq
    ang = jnp.concatenate([ang, ang], axis=-1)[:, :, None, :]
    cos, sin = jnp.cos(ang), jnp.sin(ang)
    tf = t.astype(jnp.float32)
    t1, t2 = tf[..., : d // 2], tf[..., d // 2:]
    rot = jnp.concatenate([-t2, t1], axis=-1)
    return (tf * cos + rot * sin).astype(t.dtype)


def lambda_init_fn(layer_idx):
    return 0.8 - 0.6 * math.exp(-0.3 * layer_idx)


def gmlp_spatial_gating(u, v, sgu_norm_w, w_s, b_s):
    bsz, seq = u.shape[0], u.shape[1]
    n_chunks = seq // CHUNK
    vn = rms_norm(v, sgu_norm_w, NORM_EPS).reshape(bsz, n_chunks, CHUNK, A_HEADS, A_HEAD_DIM)
    ws_causal = jnp.tril(w_s)
    mix = jnp.einsum('hts,bnshc->bnthc', ws_causal.astype(vn.dtype), vn)
    mix = mix + jnp.transpose(b_s)[None, None, :, :, None].astype(vn.dtype)
    return u * mix.reshape(bsz, seq, A_HEADS, A_HEAD_DIM)


def diff_attention(q, k, v, lam, lambda_init, subln_w):
    bsz, seq = q.shape[0], q.shape[1]
    n_blocks = seq // Q_BLOCK
    scale = B_HEAD_DIM ** -0.5
    qh = jnp.transpose(q, (0, 2, 1, 3))
    kh = jnp.transpose(k, (0, 2, 1, 3))
    vh = jnp.transpose(v, (0, 2, 1, 3))
    q_blocks = jnp.transpose(qh.reshape(bsz, 2 * B_HEADS, n_blocks, Q_BLOCK, B_HEAD_DIM), (2, 0, 1, 3, 4))
    key_idx = jnp.arange(seq)

    def one_block(args):
        qb, bi = args
        s = jnp.einsum('bhqd,bhkd->bhqk', qb, kh).astype(jnp.float32) * scale
        q_idx = bi * Q_BLOCK + jnp.arange(Q_BLOCK)
        causal = q_idx[:, None] >= key_idx[None, :]
        s = jnp.where(causal[None, None], s, -jnp.inf)
        p = jax.nn.softmax(s, axis=-1).reshape(bsz, B_HEADS, 2, Q_BLOCK, seq)
        a = p[:, :, 0] - lam * p[:, :, 1]
        return jnp.einsum('bhqk,bhkd->bhqd', a.astype(vh.dtype), vh)

    o = lax.map(one_block, (q_blocks, jnp.arange(n_blocks)))
    o = jnp.transpose(o, (1, 0, 3, 2, 4)).reshape(bsz, seq, B_HEADS, B_V_DIM)
    o = rms_norm(o, subln_w, SUBLN_EPS)
    return o * (1.0 - lambda_init)


def setup_inputs(seed: int = 0) -> dict:
    key = jax.random.key(seed)
    ks = jax.random.split(key, 20)
    f32 = jnp.float32
    x = jax.random.normal(ks[0], (BATCH, SEQ, D_MODEL), f32)
    c = jax.random.normal(ks[1], (BATCH, D_MODEL), f32)
    offset = jax.random.randint(ks[2], (BATCH, 1), 0, 1024, dtype=jnp.int32)
    positions = (jnp.arange(SEQ, dtype=jnp.int32)[None, :] + offset).astype(jnp.int32)
    norm_w = 1.0 + 0.02 * jax.random.normal(ks[3], (DEPTH, D_MODEL), f32)
    w_ada = jax.random.normal(ks[4], (DEPTH, D_MODEL, 3 * D_MODEL), f32) * (D_MODEL ** -0.5)
    b_ada = 0.02 * jax.random.normal(ks[5], (DEPTH, 3 * D_MODEL), f32)
    w_in = jax.random.normal(ks[6], (DEPTH, D_MODEL, IN_COLS), f32) * (D_MODEL ** -0.5)
    sgu_norm_w = 1.0 + 0.02 * jax.random.normal(ks[7], (DEPTH, A_HEADS, A_HEAD_DIM), f32)
    w_s = jax.random.normal(ks[8], (DEPTH, A_HEADS, CHUNK, CHUNK), f32) * (CHUNK ** -0.5)
    b_s = 1.0 + 0.02 * jax.random.normal(ks[9], (DEPTH, A_HEADS, CHUNK), f32)
    q_norm_w = 1.0 + 0.02 * jax.random.normal(ks[10], (DEPTH, B_HEAD_DIM), f32)
    k_norm_w = 1.0 + 0.02 * jax.random.normal(ks[11], (DEPTH, B_HEAD_DIM), f32)
    lambda_q1 = 0.1 * jax.random.normal(ks[12], (DEPTH, B_HEAD_DIM), f32)
    lambda_k1 = 0.1 * jax.random.normal(ks[13], (DEPTH, B_HEAD_DIM), f32)
    lambda_q2 = 0.1 * jax.random.normal(ks[14], (DEPTH, B_HEAD_DIM), f32)
    lambda_k2 = 0.1 * jax.random.normal(ks[15], (DEPTH, B_HEAD_DIM), f32)
    subln_w = 1.0 + 0.02 * jax.random.normal(ks[16], (DEPTH, B_V_DIM), f32)
    w_out = jax.random.normal(ks[17], (DEPTH, D_MIX, D_MODEL), f32) * (D_MIX ** -0.5)
    return {"x": x, "c": c, "positions": positions, "norm_w": norm_w, "w_ada": w_ada,
            "b_ada": b_ada, "w_in": w_in, "sgu_norm_w": sgu_norm_w, "w_s": w_s, "b_s": b_s,
            "q_norm_w": q_norm_w, "k_norm_w": k_norm_w, "lambda_q1": lambda_q1,
            "lambda_k1": lambda_k1, "lambda_q2": lambda_q2, "lambda_k2": lambda_k2,
            "subln_w": subln_w, "w_out": w_out}


def reference(x, c, positions, norm_w, w_ada, b_ada, w_in, sgu_norm_w, w_s, b_s,
              q_norm_w, k_norm_w, lambda_q1, lambda_k1, lambda_q2, lambda_k2, subln_w, w_out):
    bsz, seq = x.shape[0], x.shape[1]
    c_act = jax.nn.silu(c)
    for l in range(DEPTH):
        mod = c_act @ w_ada[l] + b_ada[l]
        shift, scale, gate = jnp.split(mod, 3, axis=-1)
        h = rms_norm(x, norm_w[l], NORM_EPS) * (1.0 + scale[:, None, :]) + shift[:, None, :]

        proj = jnp.einsum('bsd,dn->bsn', h, w_in[l])
        u_a, v_a, z_a, q_b, k_b, v_b, z_b = jnp.split(
            proj, np.cumsum([A_WIDTH, A_WIDTH, A_WIDTH, B_WIDTH, B_WIDTH, B_WIDTH]).tolist(), axis=-1)

        a_out = gmlp_spatial_gating(u_a.reshape(bsz, seq, A_HEADS, A_HEAD_DIM),
                                    v_a.reshape(bsz, seq, A_HEADS, A_HEAD_DIM),
                                    sgu_norm_w[l], w_s[l], b_s[l]).reshape(bsz, seq, A_WIDTH)
        a_out = a_out * jax.nn.silu(z_a)

        q = rms_norm(q_b.reshape(bsz, seq, 2 * B_HEADS, B_HEAD_DIM), q_norm_w[l], NORM_EPS)
        k = rms_norm(k_b.reshape(bsz, seq, 2 * B_HEADS, B_HEAD_DIM), k_norm_w[l], NORM_EPS)
        q = apply_rope(q, positions)
        k = apply_rope(k, positions)
        lam_init = lambda_init_fn(l)
        lam = (jnp.exp(jnp.sum(lambda_q1[l].astype(jnp.float32) * lambda_k1[l].astype(jnp.float32)))
               - jnp.exp(jnp.sum(lambda_q2[l].astype(jnp.float32) * lambda_k2[l].astype(jnp.float32)))
               + lam_init)
        b_out = diff_attention(q, k, v_b.reshape(bsz, seq, B_HEADS, B_V_DIM), lam, lam_init,
                               subln_w[l]).reshape(bsz, seq, B_WIDTH)
        b_out = b_out * jax.nn.silu(z_b)

        mixed = jnp.concatenate([a_out, b_out], axis=-1)
        out = jnp.einsum('bsm,md->bsd', mixed, w_out[l])
        x = x + gate[:, None, :] * out
    return x
```

```cpp
#include <hip/hip_runtime.h>
#include <cstdio>
#include <cstdint>
constexpr int BATCH = 8, SEQ = 2048, DMODEL = 1024, MROWS = BATCH * SEQ, NIN = 3584;
constexpr float C2Q = 0.125f * 1.4426950408889634f;
constexpr size_t MiB = 1u << 20;
constexpr size_t WS_CTL = 0, CTL_ZERO_BYTES = 1 * MiB;
constexpr size_t WS_WIN = 1 * MiB;
constexpr size_t WS_WOUT = 8 * MiB;
constexpr size_t WS_WSB = 10 * MiB;
constexpr size_t WS_MOD = 10 * MiB + 256 * 1024;
constexpr size_t WS_LAM = 10 * MiB + 384 * 1024;
constexpr size_t WS_MODP = 10 * MiB + 512 * 1024;
constexpr size_t WS_SSQ = 12 * MiB;
constexpr size_t WS_H = 13 * MiB;
constexpr size_t WS_MIXED = WS_H;
constexpr size_t WS_G = 45 * MiB;
constexpr size_t WS_VA = 61 * MiB;
constexpr size_t WS_Q = 77 * MiB;
constexpr size_t WS_K = 93 * MiB;
constexpr size_t WS_VB = 109 * MiB;
constexpr size_t WS_SZB = 125 * MiB;
constexpr size_t WS_T0 = 141 * MiB;
constexpr size_t WS_T1 = 173 * MiB;
constexpr size_t WS_END = 205 * MiB;
namespace nv {
__device__ __forceinline__ float bf2f(unsigned short h) { return __uint_as_float(((unsigned)h) << 16); }
__device__ __forceinline__ unsigned short f2bf(float f) { unsigned u = __float_as_uint(f); return (unsigned short)((u + 0x7fffu + ((u >> 16) & 1u)) >> 16); }
__device__ __forceinline__ float silu(float z) { return z / (1.f + __expf(-z)); }

__global__ void k_mod(const float* c, const float* w_ada, const float* b_ada, float* mod) {
    const int j = blockIdx.x * blockDim.x + threadIdx.x; const int b = blockIdx.y;
    if (j >= 3072) return;
    float acc = 0.f;
    for (int k = 0; k < 1024; ++k) acc += silu(c[b * 1024 + k]) * w_ada[(size_t)k * 3072 + j];
    mod[b * 3072 + j] = acc + b_ada[j];
}
__global__ void k_h(const float* x, const float* nw, const float* mod, unsigned short* H) {
    const int row = blockIdx.x, b = row / 2048, t = threadIdx.x;
    __shared__ float red[256];
    float v[4]; float s = 0.f;
    for (int i = 0; i < 4; ++i) { v[i] = x[(size_t)row * 1024 + t + 256 * i]; s += v[i] * v[i]; }
    red[t] = s; __syncthreads();
    for (int o = 128; o > 0; o >>= 1) { if (t < o) red[t] += red[t + o]; __syncthreads(); }
    const float rstd = rsqrtf(red[0] / 1024.f + 1e-6f);
    for (int i = 0; i < 4; ++i) { const int k = t + 256 * i;
        const float hv = v[i] * rstd * nw[k] * (1.f + mod[b * 3072 + 1024 + k]) + mod[b * 3072 + k];
        H[(size_t)row * 1024 + k] = f2bf(hv); }
}
__global__ void k_gemm(const unsigned short* A, const float* W, int ldw, int n0, float* C, int ldc, int K) {
    __shared__ float As[16][65]; __shared__ float Bs[16][65];
    const int tx = threadIdx.x & 15, ty = threadIdx.x >> 4; const int rm = blockIdx.y * 64, cn = blockIdx.x * 64;
    float acc[4][4] = {};
    for (int k0 = 0; k0 < K; k0 += 16) {
        for (int i = threadIdx.x; i < 1024; i += 256) { const int r = i >> 4, kk = i & 15; As[kk][r] = bf2f(A[(size_t)(rm + r) * K + k0 + kk]); }
        for (int i = threadIdx.x; i < 1024; i += 256) { const int kk = i >> 6, cc = i & 63; Bs[kk][cc] = W[(size_t)(k0 + kk) * ldw + n0 + cn + cc]; }
        __syncthreads();
        for (int kk = 0; kk < 16; ++kk) { float a[4], bb[4];
            for (int i = 0; i < 4; ++i) { a[i] = As[kk][ty * 4 + i]; bb[i] = Bs[kk][tx * 4 + i]; }
            for (int i = 0; i < 4; ++i) for (int j = 0; j < 4; ++j) acc[i][j] += a[i] * bb[j]; }
        __syncthreads();
    }
    for (int i = 0; i < 4; ++i) for (int j = 0; j < 4; ++j) C[(size_t)(rm + ty * 4 + i) * ldc + cn + tx * 4 + j] = acc[i][j];
}
__global__ void k_post_g(const float* Tu, const float* Tz, unsigned short* G) {
    const size_t i = (size_t)blockIdx.x * blockDim.x + threadIdx.x; if (i >= (size_t)16384 * 512) return;
    G[i] = f2bf(Tu[i] * silu(Tz[i]));
}
__global__ void k_post_va(const float* T, unsigned short* VA, float* SSQ) {
    const int i = blockIdx.x * blockDim.x + threadIdx.x; if (i >= 16384 * 4) return;
    const int row = i >> 2, hd = i & 3; float s = 0.f;
    for (int c = 0; c < 128; ++c) { const float v = T[(size_t)row * 512 + hd * 128 + c]; s += v * v; VA[(size_t)row * 512 + hd * 128 + c] = f2bf(v); }
    SSQ[(size_t)i * 4 + 0] = s; SSQ[(size_t)i * 4 + 1] = 0.f; SSQ[(size_t)i * 4 + 2] = 0.f; SSQ[(size_t)i * 4 + 3] = 0.f;
}
__global__ void k_post_qk(const float* T, const float* w, const int* pos, float outscale, unsigned short* O) {
    const int i = blockIdx.x * blockDim.x + threadIdx.x; if (i >= 16384 * 8) return;
    const int row = i >> 3, hd = i & 7; const float* t = T + (size_t)row * 512 + hd * 64;
    float s = 0.f; for (int d = 0; d < 64; ++d) s += t[d] * t[d];
    const float rstd = rsqrtf(s / 64.f + 1e-6f); const float p = (float)pos[row];
    for (int d = 0; d < 32; ++d) {
        const float invf = powf(10000.f, -(float)(2 * d) / 64.f); const float ang = p * invf;
        const float cs = cosf(ang), sn = sinf(ang);
        const float a = t[d] * rstd * w[d], bq = t[d + 32] * rstd * w[d + 32];
        O[(size_t)row * 512 + hd * 64 + d] = f2bf((a * cs - bq * sn) * outscale);
        O[(size_t)row * 512 + hd * 64 + d + 32] = f2bf((bq * cs + a * sn) * outscale);
    }
}
__global__ void k_post_copy(const float* T, unsigned short* O, int do_silu) {
    const size_t i = (size_t)blockIdx.x * blockDim.x + threadIdx.x; if (i >= (size_t)16384 * 512) return;
    const float v = T[i]; O[i] = f2bf(do_silu ? silu(v) : v);
}
__global__ void k_gmlp(const unsigned short* VA, const float* SSQ, const float* sgw, const float* w_s, const float* b_s, const unsigned short* G, unsigned short* MIXED) {
    const size_t i = (size_t)blockIdx.x * blockDim.x + threadIdx.x; if (i >= (size_t)16384 * 512) return;
    const int row = (int)(i >> 9), col = (int)(i & 511), hd = col >> 7, t = row & 127, r0 = row - t;
    float acc = 0.f;
    for (int s = 0; s <= t; ++s) { const int rr = r0 + s; const float* q = SSQ + ((size_t)rr * 4 + hd) * 4;
        const float rstd = rsqrtf((q[0] + q[1] + q[2] + q[3]) / 128.f + 1e-6f);
        const float vn = bf2f(f2bf(bf2f(VA[(size_t)rr * 512 + col]) * rstd * sgw[col]));
        acc += bf2f(f2bf(w_s[(size_t)hd * 16384 + t * 128 + s])) * vn; }
    MIXED[(size_t)row * 1024 + col] = f2bf(bf2f(G[i]) * (acc + b_s[hd * 128 + t]));
}
__global__ void k_attn(const unsigned short* Q, const unsigned short* K, const unsigned short* V, const unsigned short* SZB, const float* subw, const float* lamp, unsigned short* MIXED) {
    const float lam = lamp[0]; const int q = blockIdx.x, h = blockIdx.y, b = blockIdx.z, t = threadIdx.x; const size_t rb = (size_t)b * 2048;
    __shared__ float p1[2048]; __shared__ float p2[2048]; __shared__ float q1[64]; __shared__ float q2[64]; __shared__ float red[128];
    if (t < 64) { q1[t] = bf2f(Q[(rb + q) * 512 + 64 * (2 * h) + t]); q2[t] = bf2f(Q[(rb + q) * 512 + 64 * (2 * h + 1) + t]); }
    __syncthreads();
    float l1 = 0.f, l2 = 0.f;
    for (int k = t; k <= q; k += 128) { const unsigned short* kr = K + (rb + k) * 512 + 64 * (2 * h); float s1 = 0.f, s2 = 0.f;
#pragma unroll 4
        for (int d = 0; d < 64; ++d) { s1 += q1[d] * bf2f(kr[d]); s2 += q2[d] * bf2f(kr[64 + d]); }
        const float e1 = __builtin_amdgcn_exp2f(s1), e2 = __builtin_amdgcn_exp2f(s2); p1[k] = e1; p2[k] = e2; l1 += e1; l2 += e2; }
    red[t] = l1; __syncthreads(); for (int o = 64; o > 0; o >>= 1) { if (t < o) red[t] += red[t + o]; __syncthreads(); } l1 = red[0]; __syncthreads();
    red[t] = l2; __syncthreads(); for (int o = 64; o > 0; o >>= 1) { if (t < o) red[t] += red[t + o]; __syncthreads(); } l2 = red[0]; __syncthreads();
    float o = 0.f; const float i1 = 1.f / l1, i2 = lam / l2;
#pragma unroll 4
    for (int k = 0; k <= q; ++k) o += (p1[k] * i1 - p2[k] * i2) * bf2f(V[(rb + k) * 512 + 128 * h + t]);
    red[t] = o * o; __syncthreads(); for (int s = 64; s > 0; s >>= 1) { if (t < s) red[t] += red[t + s]; __syncthreads(); }
    const float rstd = rsqrtf(red[0] / 128.f + 1e-5f);
    const float y = o * rstd * subw[t] * 0.8f * bf2f(SZB[(rb + q) * 512 + 128 * h + t]);
    MIXED[(rb + q) * 1024 + 512 + 128 * h + t] = f2bf(y);
}
__global__ void k_final(const float* x, const float* mod, const float* T, float* out) {
    const size_t i = (size_t)blockIdx.x * blockDim.x + threadIdx.x; if (i >= (size_t)16384 * 1024) return;
    const int row = (int)(i >> 10), col = (int)(i & 1023), b = row / 2048;
    out[i] = x[i] + mod[b * 3072 + 2048 + col] * T[i];
}
__global__ void k_lam(const float* q1, const float* k1, const float* q2, const float* k2, float* out) {
    if (threadIdx.x == 0 && blockIdx.x == 0) { float a = 0.f, b = 0.f; for (int i = 0; i < 64; ++i) { a += q1[i] * k1[i]; b += q2[i] * k2[i]; } out[0] = expf(a) - expf(b) + 0.2f; }
}
}
extern "C" void kernel_launch(void* const* d_in, const int* in_sizes, int n_in, void* d_out, int out_size, void* d_ws, size_t ws_size, hipStream_t stream) {
    const float* x = (const float*)d_in[0]; const float* c = (const float*)d_in[1]; const int* pos = (const int*)d_in[2];
    const float* norm_w = (const float*)d_in[3]; const float* w_ada = (const float*)d_in[4]; const float* b_ada = (const float*)d_in[5];
    const float* w_in = (const float*)d_in[6]; const float* sgw = (const float*)d_in[7]; const float* w_s = (const float*)d_in[8]; const float* b_s = (const float*)d_in[9];
    const float* qnw = (const float*)d_in[10]; const float* knw = (const float*)d_in[11];
    const float* lq1 = (const float*)d_in[12]; const float* lk1 = (const float*)d_in[13]; const float* lq2 = (const float*)d_in[14]; const float* lk2 = (const float*)d_in[15];
    const float* subw = (const float*)d_in[16]; const float* w_out = (const float*)d_in[17];
    unsigned char* ws = (unsigned char*)d_ws; float* out = (float*)d_out;
    float* MOD = (float*)(ws + WS_MOD); float* LAM = (float*)(ws + WS_LAM); float* SSQ = (float*)(ws + WS_SSQ);
    unsigned short* H = (unsigned short*)(ws + WS_H); unsigned short* MIXED = (unsigned short*)(ws + WS_MIXED);
    unsigned short* G = (unsigned short*)(ws + WS_G); unsigned short* VA = (unsigned short*)(ws + WS_VA);
    unsigned short* Q = (unsigned short*)(ws + WS_Q); unsigned short* K = (unsigned short*)(ws + WS_K);
    unsigned short* VB = (unsigned short*)(ws + WS_VB); unsigned short* SZB = (unsigned short*)(ws + WS_SZB);
    float* T0 = (float*)(ws + WS_T0); float* T1 = (float*)(ws + WS_T1);
    const int EB = (16384 * 512 + 255) / 256;
    nv::k_mod<<<dim3(12, 8), 256, 0, stream>>>(c, w_ada, b_ada, MOD);
    nv::k_lam<<<1, 64, 0, stream>>>(lq1, lk1, lq2, lk2, LAM);
    nv::k_h<<<16384, 256, 0, stream>>>(x, norm_w, MOD, H);
    const dim3 gg(8, 256);
    nv::k_gemm<<<gg, 256, 0, stream>>>(H, w_in, NIN, 0, T0, 512, 1024);
    nv::k_gemm<<<gg, 256, 0, stream>>>(H, w_in, NIN, 1024, T1, 512, 1024);
    nv::k_post_g<<<EB, 256, 0, stream>>>(T0, T1, G);
    nv::k_gemm<<<gg, 256, 0, stream>>>(H, w_in, NIN, 512, T0, 512, 1024);
    nv::k_post_va<<<(16384 * 4 + 255) / 256, 256, 0, stream>>>(T0, VA, SSQ);
    nv::k_gemm<<<gg, 256, 0, stream>>>(H, w_in, NIN, 1536, T0, 512, 1024);
    nv::k_post_qk<<<(16384 * 8 + 255) / 256, 256, 0, stream>>>(T0, qnw, pos, C2Q, Q);
    nv::k_gemm<<<gg, 256, 0, stream>>>(H, w_in, NIN, 2048, T1, 512, 1024);
    nv::k_post_qk<<<(16384 * 8 + 255) / 256, 256, 0, stream>>>(T1, knw, pos, 1.0f, K);
    nv::k_gemm<<<gg, 256, 0, stream>>>(H, w_in, NIN, 2560, T0, 512, 1024);
    nv::k_post_copy<<<EB, 256, 0, stream>>>(T0, VB, 0);
    nv::k_gemm<<<gg, 256, 0, stream>>>(H, w_in, NIN, 3072, T1, 512, 1024);
    nv::k_post_copy<<<EB, 256, 0, stream>>>(T1, SZB, 1);
    nv::k_gmlp<<<EB, 256, 0, stream>>>(VA, SSQ, sgw, w_s, b_s, G, MIXED);
    nv::k_attn<<<dim3(2048, 4, 8), 128, 0, stream>>>(Q, K, VB, SZB, subw, LAM, MIXED);
    nv::k_gemm<<<dim3(16, 256), 256, 0, stream>>>(MIXED, w_out, 1024, 0, T0, 1024, 1024);
    nv::k_final<<<(16384 * 1024 + 255) / 256, 256, 0, stream>>>(x, MOD, T0, out);
}
```

```cpp
#define MK_N_LAUNCHES 5
#include <hip/hip_runtime.h>
#include <cstdio>
#include <cstdint>
constexpr int BATCH = 8, SEQ = 2048, DMODEL = 1024, MROWS = BATCH * SEQ, NIN = 3584;
constexpr float C2Q = 0.125f * 1.4426950408889634f;
constexpr size_t MiB = 1u << 20;
constexpr size_t WS_CTL = 0, CTL_ZERO_BYTES = 1 * MiB;
constexpr size_t WS_WIN = 1 * MiB;
constexpr size_t WS_WOUT = 8 * MiB;
constexpr size_t WS_WSB = 10 * MiB;
constexpr size_t WS_MOD = 10 * MiB + 256 * 1024;
constexpr size_t WS_LAM = 10 * MiB + 384 * 1024;
constexpr size_t WS_MODP = 10 * MiB + 512 * 1024;
constexpr size_t WS_SSQ = 12 * MiB;
constexpr size_t WS_H = 13 * MiB;
constexpr size_t WS_MIXED = WS_H;
constexpr size_t WS_G = 45 * MiB;
constexpr size_t WS_VA = 61 * MiB;
constexpr size_t WS_Q = 77 * MiB;
constexpr size_t WS_K = 93 * MiB;
constexpr size_t WS_VB = 109 * MiB;
constexpr size_t WS_SZB = 125 * MiB;
constexpr size_t WS_T0 = 141 * MiB;
constexpr size_t WS_T1 = 173 * MiB;
constexpr size_t WS_END = 205 * MiB;
#define GAS __attribute__((address_space(1)))
#define LAS __attribute__((address_space(3)))
typedef unsigned short bf16;
typedef unsigned v4u __attribute__((ext_vector_type(4)));
typedef float f32x4 __attribute__((ext_vector_type(4)));
typedef short bf16x8 __attribute__((ext_vector_type(8)));
typedef GAS unsigned gu32;
typedef GAS unsigned long long gu64;
#define RLX_AGENT __ATOMIC_RELAXED, __HIP_MEMORY_SCOPE_AGENT
#define LDS_WAIT() asm volatile("s_waitcnt lgkmcnt(0)" ::: "memory")
#define VM_WAIT() asm volatile("s_waitcnt vmcnt(0)" ::: "memory")
__device__ __forceinline__ unsigned long long rt() { return __builtin_amdgcn_s_memrealtime(); }
__device__ __forceinline__ unsigned f2bf(float f) { unsigned u = __builtin_bit_cast(unsigned, f); return (u + 0x7fffu + ((u >> 16) & 1u)) >> 16; }
__device__ __forceinline__ unsigned pk2(float lo, float hi) { return f2bf(lo) | (f2bf(hi) << 16); }
#define XB_TMO      128
#define XB_XCNT(j)  (256  + 64 * (j))
#define XB_XSUB(j)  (1280 + 64 * (j))
#define XB_XGEN(j)  (2304 + 64 * (j))
#define XB_TOP      3328
#define XB_TOPGEN   3392
#define XCD_BAR_WORDS 3456
#define XB_SPIN_CAP (1u << 18)

__device__ __forceinline__ unsigned xb_ld(unsigned* p)              { return __hip_atomic_load(p, __ATOMIC_RELAXED, __HIP_MEMORY_SCOPE_AGENT); }
__device__ __forceinline__ unsigned xb_add(unsigned* p, unsigned v) { return __hip_atomic_fetch_add(p, v, __ATOMIC_RELAXED, __HIP_MEMORY_SCOPE_AGENT); }
__device__ __forceinline__ unsigned xb_xcc_id() { return (unsigned)__builtin_amdgcn_s_getreg((3 << 11) | 20) & 0xFu; }
#define XB_SPIN(cond, bar) do { unsigned _sp = 0; while (cond) { __builtin_amdgcn_s_sleep(1); \
    if ((++_sp & 255u) == 0u) { if (xb_ld(&(bar)[XB_TMO])) break; if (_sp > XB_SPIN_CAP) { atomicAdd(&(bar)[XB_TMO], 1u); break; } } } } while (0)

struct XcdBarrier {
    unsigned* bar; unsigned x;
    volatile LAS unsigned* st;
};

__device__ __forceinline__ XcdBarrier xcd_barrier_post(unsigned* bar, volatile LAS unsigned* st) {
    XcdBarrier b; b.bar = bar; b.x = xb_xcc_id(); b.st = st;
    if (threadIdx.x == 0) (void)xb_add(&bar[XB_XCNT(b.x)], 1u);
    return b;
}
__device__ __forceinline__ void xcd_barrier_complete(unsigned* bar, unsigned x, unsigned& nloc, unsigned& nx) {
    const unsigned G = gridDim.x * gridDim.y * gridDim.z;
    unsigned sum, cnt, mine, sp = 0u;
    for (;;) {
        sum = 0u; cnt = 0u; mine = 0u;
#pragma unroll
        for (unsigned j = 0; j < 16; ++j) { const unsigned c = xb_ld(&bar[XB_XCNT(j)]); sum += c; cnt += (c > 0u) ? 1u : 0u; mine = (j == x) ? c : mine; }
        if (sum == G) break;
        __builtin_amdgcn_s_sleep(1);
        if ((++sp & 255u) == 0u) { if (xb_ld(&bar[XB_TMO])) break; if (sp > XB_SPIN_CAP) { atomicAdd(&bar[XB_TMO], 1u); break; } }
    }
    nloc = mine > 0u ? mine : 1u; nx = cnt > 0u ? cnt : 1u;
}

__device__ __forceinline__ void xcd_barrier(const XcdBarrier& b) {
    asm volatile("s_waitcnt vmcnt(0)" ::: "memory");
    __syncthreads();
    if (threadIdx.x == 0) {
        unsigned* bar = b.bar;
        __builtin_amdgcn_s_waitcnt(0);
        unsigned nloc = b.st[0], nx = b.st[1];
        if (nloc == 0u) { xcd_barrier_complete(bar, b.x, nloc, nx); b.st[0] = nloc; b.st[1] = nx; }
        const unsigned old = xb_add(&bar[XB_XSUB(b.x)], 1u);
        const unsigned gen = old / nloc;
        if (old + 1u == (gen + 1u) * nloc) {
            __builtin_amdgcn_fence(__ATOMIC_RELEASE, "agent");
            asm volatile("s_waitcnt vmcnt(0)" ::: "memory");
            const unsigned og = xb_add(&bar[XB_TOP], 1u);
            const unsigned tg = og / nx;
            if (og + 1u == (tg + 1u) * nx) xb_add(&bar[XB_TOPGEN], 1u);
            else XB_SPIN(xb_ld(&bar[XB_TOPGEN]) == tg, bar);
            __builtin_amdgcn_fence(__ATOMIC_ACQUIRE, "agent");
            xb_add(&bar[XB_XGEN(b.x)], 1u);
            asm volatile("s_waitcnt vmcnt(0)" ::: "memory");
        } else {
            XB_SPIN(xb_ld(&bar[XB_XGEN(b.x)]) == gen, bar);
            __builtin_amdgcn_fence(__ATOMIC_ACQUIRE, "agent");
            asm volatile("s_waitcnt vmcnt(0)" ::: "memory");
        }
    }
    __syncthreads();
}
namespace pg8 {
#define PG8_LAS __attribute__((address_space(3)))
typedef unsigned short bf16_t;
typedef short bf16x8 __attribute__((ext_vector_type(8)));
typedef float f32x4 __attribute__((ext_vector_type(4)));
typedef unsigned u32x4 __attribute__((ext_vector_type(4)));
constexpr int BM = 256, BK = 64, HALF = 128, HTB = HALF * BK * 2  , STAGE_BYTES = 8 * HTB, NXCD = 8, WGM = 8;

__host__ __device__ __forceinline__ int lds_byte(int r, int c) { const int st = (r >> 4) * 2 + (c >> 5), rr = r & 15, cc = c & 31, ob = rr * 64 + cc * 2; return st * 1024 + (ob ^ (((ob >> 9) & 1) << 5)); }
__host__ __device__ __forceinline__ void stage_rc(int b, int& R, int& C) { const int st = b / 1024, sb = b % 1024, swz = sb ^ (((sb >> 9) & 1) << 5); R = (st >> 1) * 16 + swz / 64; C = (st & 1) * 32 + (swz % 64) / 2; }
__host__ __device__ __forceinline__ int perm32(int rho) { const int n = rho >> 4, i = rho & 15; return 8 * (i >> 2) + 4 * n + (i & 3); }

struct Unit { int pm, pn; };
struct Gemm { const bf16_t* A; const bf16_t* Bt; int M, N, K; };

struct StaticOrder {
    int nM, nN, nwg, G, c;
    __host__ __device__ void init(int M, int N, int G_, int c_) { nM = M / BM; nN = N / BM; nwg = nM * nN; G = G_; c = c_; }
    __host__ __device__ bool next(int i, Unit& u) const {
        const long L = (long)i * G + c; if (L >= nwg) return false;
        int wgid = (int)L; { const int q = nwg / NXCD, r = nwg % NXCD, xcd = wgid % NXCD, off = wgid / NXCD; wgid = (xcd < r ? xcd * (q + 1) : r * (q + 1) + (xcd - r) * q) + off; }
        const int nig = WGM * nN, gid = wgid / nig, fm = gid * WGM, gsz = (nM - fm) < WGM ? (nM - fm) : WGM;
        u.pm = fm + ((wgid % nig) % gsz); u.pn = (wgid % nig) / gsz; return true;
    }
    __device__ __forceinline__ void a_ready(const Unit&) const {}
    __device__ __forceinline__ void done(const Unit&) const {}
};

__device__ __forceinline__ unsigned cvt_pk_bf16(float lo, float hi) { unsigned r; asm volatile("v_cvt_pk_bf16_f32 %0, %1, %2" : "=v"(r) : "v"(lo), "v"(hi)); return r; }
typedef float f32x2 __attribute__((ext_vector_type(2)));
__device__ __forceinline__ float silu_f(float z) { return z * __builtin_amdgcn_rcpf(1.f + __builtin_amdgcn_exp2f(-1.4426950408889634f * z)); }
__device__ __forceinline__ void store8(bf16_t* p, const f32x4& a, const f32x4& b) {
    u32x4 w; w.x = cvt_pk_bf16(a[0], a[1]); w.y = cvt_pk_bf16(a[2], a[3]); w.z = cvt_pk_bf16(b[0], b[1]); w.w = cvt_pk_bf16(b[2], b[3]); *(u32x4*)p = w; }
struct Epi1 {
    static constexpr bool PERM = true, AFTER_DRAIN = false;
    bf16_t *G, *VA, *Q, *K, *VB, *SZB; float* SSQ; const int* pos; const float *qnw, *knw;
    __device__ __forceinline__ void operator()(const f32x4 (&acc)[2][2][4][2], const Unit& u, int wr, int wc, int fr, int fq) const {
        const int row0 = u.pm * BM + wr * 64 + fr; const int pn = u.pn;
        if (pn < 4) {
            bf16_t* base = G + (size_t)row0 * 512 + pn * 128 + wc * 32 + 8 * fq;
#pragma unroll
            for (int ai = 0; ai < 2; ++ai)
#pragma unroll
                for (int m = 0; m < 4; ++m) { f32x4 g0, g1;
#pragma unroll
                    for (int e = 0; e < 4; ++e) { g0[e] = acc[ai][0][m][0][e] * silu_f(acc[ai][1][m][0][e]); g1[e] = acc[ai][0][m][1][e] * silu_f(acc[ai][1][m][1][e]); }
                    store8(base + (size_t)(ai * HALF + m * 16) * 512, g0, g1); }
        } else if (pn < 6) {
#pragma unroll
            for (int ai = 0; ai < 2; ++ai)
#pragma unroll
                for (int m = 0; m < 4; ++m) { const int row = row0 + ai * HALF + m * 16;
#pragma unroll
                    for (int bj = 0; bj < 2; ++bj) { const f32x4 a = acc[ai][bj][m][0], b = acc[ai][bj][m][1];
                        store8(VA + (size_t)row * 512 + (pn - 4) * 256 + bj * 128 + wc * 32 + 8 * fq, a, b);
                        float s = (a[0] * a[0] + a[1] * a[1]) + (a[2] * a[2] + a[3] * a[3]) + (b[0] * b[0] + b[1] * b[1]) + (b[2] * b[2] + b[3] * b[3]);
                        s += __shfl_xor(s, 16); s += __shfl_xor(s, 32);
                        if (fq == 0) SSQ[((size_t)row * 4 + (pn - 4) * 2 + bj) * 4 + wc] = s; } }
        } else if (pn < 10) {
            const bool isq = pn < 8; const int head = 4 * (pn - (isq ? 6 : 8)) + wc;
            bf16_t* O = isq ? Q : K; const float* nw = isq ? qnw : knw; const float osc = isq ? C2Q : 1.0f;
            float w[2][2][4], invf[2][4];
#pragma unroll
            for (int n = 0; n < 2; ++n)
#pragma unroll
                for (int e = 0; e < 4; ++e) { const int i = 8 * fq + 4 * n + e; w[0][n][e] = nw[i]; w[1][n][e] = nw[32 + i];
                    invf[n][e] = __builtin_amdgcn_exp2f(-(float)i * 0.41524101186092029f) * 0.15915494309189535f; }
#pragma unroll
            for (int ai = 0; ai < 2; ++ai)
#pragma unroll
                for (int m = 0; m < 4; ++m) { const int row = row0 + ai * HALF + m * 16; const float p = (float)pos[row];
                    float ss = 0.f;
#pragma unroll
                    for (int bj = 0; bj < 2; ++bj)
#pragma unroll
                        for (int n = 0; n < 2; ++n) { const f32x4 a = acc[ai][bj][m][n]; ss += (a[0] * a[0] + a[1] * a[1]) + (a[2] * a[2] + a[3] * a[3]); }
                    ss += __shfl_xor(ss, 16); ss += __shfl_xor(ss, 32);
                    const float rstd = __builtin_amdgcn_rsqf(ss * (1.0f / 64.0f) + 1e-6f);
                    f32x4 o0[2], o1[2];
#pragma unroll
                    for (int n = 0; n < 2; ++n)
#pragma unroll
                        for (int e = 0; e < 4; ++e) { const float rev = __builtin_amdgcn_fractf(p * invf[n][e]);
                            const float sn = __builtin_amdgcn_sinf(rev), cs = __builtin_amdgcn_cosf(rev);
                            const float a = acc[ai][0][m][n][e] * rstd * w[0][n][e], b = acc[ai][1][m][n][e] * rstd * w[1][n][e];
                            o0[n][e] = (a * cs - b * sn) * osc; o1[n][e] = (b * cs + a * sn) * osc; }
                    bf16_t* op = O + (size_t)row * 512 + 64 * head + 8 * fq;
                    store8(op, o0[0], o0[1]); store8(op + 32, o1[0], o1[1]); }
        } else {
            const bool sil = pn >= 12; bf16_t* O = sil ? SZB : VB; const int cbase = (pn - (sil ? 12 : 10)) * 256 + wc * 32 + 8 * fq;
#pragma unroll
            for (int ai = 0; ai < 2; ++ai)
#pragma unroll
                for (int m = 0; m < 4; ++m) { const int row = row0 + ai * HALF + m * 16;
#pragma unroll
                    for (int bj = 0; bj < 2; ++bj) { f32x4 a = acc[ai][bj][m][0], b = acc[ai][bj][m][1];
                        if (sil) {
#pragma unroll
                            for (int e = 0; e < 4; ++e) { a[e] = silu_f(a[e]); b[e] = silu_f(b[e]); } }
                        store8(O + (size_t)row * 512 + cbase + bj * 128, a, b); } }
        }
    }
};
struct Epi2 {
    static constexpr bool PERM = false, AFTER_DRAIN = false;
    const float* x; const float* mod; float* out;
    __device__ __forceinline__ void operator()(const f32x4 (&acc)[2][2][4][2], const Unit& u, int wr, int wc, int fr, int fq) const {
        const int row0 = u.pm * BM + wr * 64 + fr; const int b = (u.pm * BM) >> 11; const int col0 = u.pn * BM + wc * 32 + 4 * fq;
#pragma unroll
        for (int bj = 0; bj < 2; ++bj)
#pragma unroll
            for (int n = 0; n < 2; ++n) { const f32x4 gate = *(const f32x4*)(mod + b * 3072 + 2048 + col0 + bj * HALF + n * 16);
#pragma unroll
                for (int ai = 0; ai < 2; ++ai)
#pragma unroll
                    for (int m = 0; m < 4; ++m) { const size_t off = (size_t)(row0 + ai * HALF + m * 16) * 1024 + col0 + bj * HALF + n * 16;
                        const f32x4 xv = *(const f32x4*)(x + off); *(f32x4*)(out + off) = xv + gate * acc[ai][bj][m][n]; } }
    }
};
template <class Epi, class Sched, bool ALIGN_EPI = false, bool SP2 = false>
__device__ __forceinline__ void gemm_phase(PG8_LAS unsigned char* lds, const Gemm g, const Sched& S, const Epi& E) {
    const int tid = threadIdx.x, wid = __builtin_amdgcn_readfirstlane(tid >> 6), lane = tid & 63, wr = wid >> 2, wc = wid & 3, fr = lane & 15, fq = lane >> 4;
    const int K = g.K, nt = K / BK;
    unsigned voffA[2], voffB[2];
#pragma unroll
    for (int i = 0; i < 2; ++i) { int R, C; stage_rc(tid * 16 + i * 8192, R, C); const int Rb = Epi::PERM ? ((R & ~31) + perm32(R & 31)) : R;
        voffA[i] = (unsigned)(R * K + C) * 2u; voffB[i] = (unsigned)(Rb * K + C) * 2u; }
    const size_t kstep = (size_t)(BK * 2);
    const size_t hstep = (size_t)HALF * K * 2;
    const size_t tstep = 2 * hstep;
    const unsigned ldsw = (unsigned)wid * 1024u;
    const int aoff = lds_byte(wr * 64 + fr, fq * 8), boff = lds_byte(wc * 32 + fr, fq * 8);
#define PG8_SA(b, h) (((b) * 2 + (h)) * HTB)
#define PG8_SB(b, h) ((4 + (b) * 2 + (h)) * HTB)
#define PG8_STAGE(bufoff, gbase, voff) do { _Pragma("unroll") for (int _i = 0; _i < 2; ++_i) \
        __builtin_amdgcn_global_load_lds((const unsigned*)((const char*)(gbase) + (voff)[_i]), (PG8_LAS unsigned*)(lds + (bufoff) + ldsw + _i * 8192), 16, 0, 0); } while (0)
#define PG8_LDA(dst, b, h) do { _Pragma("unroll") for (int m = 0; m < 4; ++m) _Pragma("unroll") for (int k = 0; k < 2; ++k) dst[m][k] = *(const PG8_LAS bf16x8*)(lds + PG8_SA(b, h) + aoff + m * 2048 + k * 1024); } while (0)
#define PG8_LDB(dst, b, h) do { _Pragma("unroll") for (int n = 0; n < 2; ++n) _Pragma("unroll") for (int k = 0; k < 2; ++k) dst[n][k] = *(const PG8_LAS bf16x8*)(lds + PG8_SB(b, h) + boff + n * 2048 + k * 1024); } while (0)
#define PG8_MMA(ai, bj, At, Bt) do { __builtin_amdgcn_s_setprio(1); _Pragma("unroll") for (int m = 0; m < 4; ++m) _Pragma("unroll") for (int n = 0; n < 2; ++n) _Pragma("unroll") for (int k = 0; k < 2; ++k) \
        acc[ai][bj][m][n] = __builtin_amdgcn_mfma_f32_16x16x32_bf16(Bt[n][k], At[m][k], acc[ai][bj][m][n], 0, 0, 0); __builtin_amdgcn_s_setprio(0); } while (0)
#define PG8_WAIT_V(n) asm volatile("s_waitcnt vmcnt(" #n ")" ::: "memory")
#define PG8_WAIT_L(n) asm volatile("s_waitcnt lgkmcnt(" #n ")" ::: "memory")
#define PG8_BAR __builtin_amdgcn_s_barrier()
#define PG8_SCHED __builtin_amdgcn_sched_barrier(0)
    Unit cur, nxt; int ui = 0;
    if (!S.next(0, cur)) return;
    f32x4 acc[2][2][4][2];
#pragma unroll
    for (int a = 0; a < 2; ++a)
#pragma unroll
        for (int b = 0; b < 2; ++b)
#pragma unroll
            for (int m = 0; m < 4; ++m)
#pragma unroll
                for (int n = 0; n < 2; ++n) acc[a][b][m][n] = (f32x4){0.f, 0.f, 0.f, 0.f};
    bf16x8 At[4][2], B0[2][2], B1[2][2];
    const char* cA = (const char*)g.A + (size_t)cur.pm * tstep; const char* cB = (const char*)g.Bt + (size_t)cur.pn * tstep;
    S.a_ready(cur);
    if constexpr (SP2) {
        PG8_STAGE(PG8_SB(0, 0), cB, voffB); PG8_STAGE(PG8_SB(0, 1), cB + hstep, voffB); PG8_STAGE(PG8_SA(0, 0), cA, voffA); PG8_STAGE(PG8_SA(0, 1), cA + hstep, voffA);
        if (wr == 1) PG8_BAR;
        PG8_WAIT_V(2); PG8_BAR;
        PG8_STAGE(PG8_SB(1, 0), cB + kstep, voffB); PG8_STAGE(PG8_SA(1, 0), cA + kstep, voffA); PG8_STAGE(PG8_SB(1, 1), cB + hstep + kstep, voffB);
        PG8_WAIT_V(6); PG8_BAR;
    } else {
        PG8_STAGE(PG8_SB(0, 0), cB, voffB); PG8_STAGE(PG8_SA(0, 0), cA, voffA); PG8_STAGE(PG8_SB(0, 1), cB + hstep, voffB); PG8_STAGE(PG8_SA(0, 1), cA + hstep, voffA);
        if (wr == 1) PG8_BAR;
        PG8_WAIT_V(4); PG8_BAR;
        PG8_STAGE(PG8_SB(1, 0), cB + kstep, voffB); PG8_STAGE(PG8_SA(1, 0), cA + kstep, voffA); PG8_STAGE(PG8_SB(1, 1), cB + hstep + kstep, voffB);
        PG8_WAIT_V(6); PG8_BAR;
    }
    for (;;) {
        const bool has_next = S.next(ui + 1, nxt);
        const char* nA = has_next ? (const char*)g.A + (size_t)nxt.pm * tstep : cA; const char* nB = has_next ? (const char*)g.Bt + (size_t)nxt.pn * tstep : cB;
        for (int t = 0; t < nt; t += 2) {
            const bool last = (t == nt - 2);
            const char* a1 = cA + (size_t)(t + 1) * kstep;
            const char* a2 = last ? nA : cA + (size_t)(t + 2) * kstep; const char* b2 = last ? nB : cB + (size_t)(t + 2) * kstep;
            const char* a3 = a2 + kstep; const char* b3 = b2 + kstep;
            if (last && has_next) S.a_ready(nxt);
            if constexpr (SP2) {
            PG8_LDB(B0, 0, 0); PG8_LDB(B1, 0, 1); PG8_SCHED; PG8_LDA(At, 0, 0); PG8_STAGE(PG8_SA(1, 1), a1 + hstep, voffA);
            PG8_WAIT_V(8); PG8_WAIT_L(0); PG8_BAR; PG8_MMA(0, 0, At, B0); PG8_MMA(0, 1, At, B1); PG8_BAR; PG8_SCHED;
            PG8_LDA(At, 0, 1); PG8_STAGE(PG8_SB(0, 0), b2, voffB); PG8_STAGE(PG8_SB(0, 1), b2 + hstep, voffB); PG8_STAGE(PG8_SA(0, 0), a2, voffA);
            PG8_WAIT_V(8); PG8_WAIT_L(0); PG8_BAR; PG8_MMA(1, 0, At, B0); PG8_MMA(1, 1, At, B1); PG8_BAR; PG8_SCHED;
            PG8_LDB(B0, 1, 0); PG8_LDB(B1, 1, 1); PG8_SCHED; PG8_LDA(At, 1, 0); PG8_STAGE(PG8_SA(0, 1), a2 + hstep, voffA);
            PG8_WAIT_V(8); PG8_WAIT_L(0); PG8_BAR; PG8_MMA(0, 0, At, B0); PG8_MMA(0, 1, At, B1); PG8_BAR; PG8_SCHED;
            PG8_LDA(At, 1, 1); PG8_STAGE(PG8_SB(1, 0), b3, voffB); PG8_STAGE(PG8_SB(1, 1), b3 + hstep, voffB); PG8_STAGE(PG8_SA(1, 0), a3, voffA);
            PG8_WAIT_V(8); PG8_WAIT_L(0); PG8_BAR; PG8_MMA(1, 0, At, B0); PG8_MMA(1, 1, At, B1); PG8_BAR; PG8_SCHED;
            } else {
            PG8_LDB(B0, 0, 0); PG8_SCHED; PG8_LDA(At, 0, 0); PG8_STAGE(PG8_SA(1, 1), a1 + hstep, voffA);
            PG8_WAIT_L(8); PG8_BAR; PG8_WAIT_L(0); PG8_MMA(0, 0, At, B0); PG8_BAR; PG8_SCHED;
            PG8_LDB(B1, 0, 1); PG8_STAGE(PG8_SB(0, 0), b2, voffB);
            PG8_BAR; PG8_WAIT_L(0); PG8_MMA(0, 1, At, B1); PG8_BAR;
            PG8_LDA(At, 0, 1); PG8_STAGE(PG8_SA(0, 0), a2, voffA);
            PG8_BAR; PG8_WAIT_L(0); PG8_MMA(1, 0, At, B0); PG8_BAR; PG8_SCHED;
            PG8_STAGE(PG8_SB(0, 1), b2 + hstep, voffB);
            PG8_WAIT_V(6); PG8_BAR; PG8_MMA(1, 1, At, B1); PG8_BAR;
            PG8_LDB(B0, 1, 0); PG8_SCHED; PG8_LDA(At, 1, 0); PG8_STAGE(PG8_SA(0, 1), a2 + hstep, voffA);
            PG8_WAIT_L(8); PG8_BAR; PG8_WAIT_L(0); PG8_MMA(0, 0, At, B0); PG8_BAR; PG8_SCHED;
            PG8_LDB(B1, 1, 1); PG8_STAGE(PG8_SB(1, 0), b3, voffB);
            PG8_BAR; PG8_WAIT_L(0); PG8_MMA(0, 1, At, B1); PG8_BAR;
            PG8_LDA(At, 1, 1); PG8_STAGE(PG8_SA(1, 0), a3, voffA);
            PG8_BAR; PG8_WAIT_L(0); PG8_MMA(1, 0, At, B0); PG8_BAR; PG8_SCHED;
            PG8_STAGE(PG8_SB(1, 1), b3 + hstep, voffB);
            PG8_WAIT_V(6); PG8_BAR; PG8_MMA(1, 1, At, B1); PG8_BAR;
            }
        }
        if constexpr (ALIGN_EPI) { if (wr == 0) PG8_BAR; }
        if constexpr (!Epi::AFTER_DRAIN) { E(acc, cur, wr, wc, fr, fq); S.done(cur); }
        if (!has_next) break;
#pragma unroll
        for (int a = 0; a < 2; ++a)
#pragma unroll
            for (int b = 0; b < 2; ++b)
#pragma unroll
                for (int m = 0; m < 4; ++m)
#pragma unroll
                    for (int n = 0; n < 2; ++n) acc[a][b][m][n] = (f32x4){0.f, 0.f, 0.f, 0.f};
        cur = nxt; cA = nA; cB = nB; ++ui;
        if constexpr (ALIGN_EPI) { if (wr == 1) PG8_BAR; }
    }
    PG8_WAIT_V(0);
    if constexpr (!ALIGN_EPI) { if (wr == 0) PG8_BAR; }
    PG8_BAR;
    if constexpr (Epi::AFTER_DRAIN) { E.fused(acc, cur, wr, wc, fr, fq, lds, wid, lane); S.done(cur); }
#undef PG8_SA
#undef PG8_SB
#undef PG8_STAGE
#undef PG8_LDA
#undef PG8_LDB
#undef PG8_MMA
#undef PG8_WAIT_V
#undef PG8_WAIT_L
#undef PG8_BAR
#undef PG8_SCHED
}
}
namespace att {
typedef unsigned short bf16_t;
typedef short bf16x8 __attribute__((ext_vector_type(8)));
typedef short s16x4 __attribute__((ext_vector_type(4)));
typedef short v4i16_t __attribute__((ext_vector_type(4)));
typedef float f32x4 __attribute__((ext_vector_type(4)));
typedef float f32x16 __attribute__((ext_vector_type(16)));
typedef unsigned u32x4 __attribute__((ext_vector_type(4)));
#define ALAS __attribute__((address_space(3)))
constexpr int KOFF0 = 0, KOFF1 = 8192, VOFF = 16384, BUFB = 32768;
constexpr int XOFF = 65536, XROW = 132;
constexpr int WSF_OFF = XOFF + 128 * XROW * 4;
constexpr int ATT_LDS_END = WSF_OFF + 8 * 256;
__device__ __forceinline__ int crow(int r, int hi) { return (r & 3) + 8 * (r >> 2) + 4 * hi; }
__device__ __forceinline__ unsigned cvtpk(float lo, float hi) { typedef float f2 __attribute__((ext_vector_type(2))); typedef __bf16 b2 __attribute__((ext_vector_type(2))); f2 v = {lo, hi}; b2 b = __builtin_convertvector(v, b2); return __builtin_bit_cast(unsigned, b); }
__device__ __forceinline__ s16x4 vtr(const ALAS unsigned char* p) { return __builtin_bit_cast(s16x4, __builtin_amdgcn_ds_read_tr16_b64_v4i16((ALAS v4i16_t*)p)); }
__device__ __forceinline__ float bf2f(unsigned short h) { return __uint_as_float(((unsigned)h) << 16); }
#define AMFMA(a, b, c) __builtin_amdgcn_mfma_f32_32x32x16_bf16(a, b, c, 0, 0, 0)

__device__ __forceinline__ void attn_unit(ALAS unsigned char* lds, int b, int h, int qb, const bf16_t* Q, const bf16_t* K, const bf16_t* V, const bf16_t* SZB, bf16_t* MIXED, const float* subw, float lam) {
    const int tid = threadIdx.x, lane = tid & 63, r32 = lane & 31, hi = lane >> 5;
    const int wid = __builtin_amdgcn_readfirstlane(tid >> 6), g = wid & 3, sh = wid >> 2;
    const size_t rowbase = (size_t)b * 2048; const int q0 = qb * 128; const int NT = 2 * (qb + 1);
    const bf16_t* Qw = Q + (rowbase + q0 + 32 * g + r32) * 512 + 64 * (2 * h + sh);
    bf16x8 qr[4];
#pragma unroll
    for (int d0 = 0; d0 < 4; ++d0) qr[d0] = *(const bf16x8*)(Qw + 16 * d0 + 8 * hi);
    const bf16_t* ksrc = K + (rowbase + lane) * 512 + 64 * (2 * h) + 8 * wid;
    const bf16_t* vsrc = V + (rowbase + 16 * (wid & 3) + (lane >> 2)) * 512 + 128 * h + 32 * (wid >> 2) + 8 * (lane & 3);
    const int kd0 = KOFF0 + wid * 1024, kd1 = KOFF1 + wid * 1024, vd0 = VOFF + ((wid >> 2) * 4 + (wid & 3)) * 1024, vd1 = VOFF + ((2 + (wid >> 2)) * 4 + (wid & 3)) * 1024;
#define ADMA(t, bo) do { const size_t go_ = (size_t)(t) * 64 * 512; \
        __builtin_amdgcn_global_load_lds((const unsigned*)(ksrc + go_), (ALAS unsigned*)(lds + (bo) + kd0), 16, 0, 0); \
        __builtin_amdgcn_global_load_lds((const unsigned*)(ksrc + go_ + 64), (ALAS unsigned*)(lds + (bo) + kd1), 16, 0, 0); \
        __builtin_amdgcn_global_load_lds((const unsigned*)(vsrc + go_), (ALAS unsigned*)(lds + (bo) + vd0), 16, 0, 0); \
        __builtin_amdgcn_global_load_lds((const unsigned*)(vsrc + go_ + 64), (ALAS unsigned*)(lds + (bo) + vd1), 16, 0, 0); } while (0)
    const ALAS unsigned char* kp = lds + (sh ? KOFF1 : KOFF0) + hi * 1024 + r32 * 16;
    const ALAS unsigned char* vp = lds + VOFF + ((lane >> 4) & 1) * 32 + (lane & 3) * 8 + (4 * hi + ((lane & 15) >> 2)) * 64;
    f32x16 o[4]; o[0] = f32x16{}; o[1] = f32x16{}; o[2] = f32x16{}; o[3] = f32x16{};
    float l = 0.f;
    ADMA(0, 0);
    for (int t = 0; t < NT; ++t) {
        __syncthreads();
        if (t + 1 < NT) ADMA(t + 1, ((t + 1) & 1) * BUFB);
        const int rel = t - 2 * qb;
        const bool skip = (rel == 1 && g < 2);
        if (!skip) {
            const int bo = (t & 1) * BUFB;
            f32x16 p0 = f32x16{}, p1 = f32x16{};
#pragma unroll
            for (int d0 = 0; d0 < 4; ++d0) { const bf16x8 k0 = *(const ALAS bf16x8*)(kp + bo + d0 * 2048), k1 = *(const ALAS bf16x8*)(kp + bo + d0 * 2048 + 512);
                p0 = AMFMA(k0, qr[d0], p0); p1 = AMFMA(k1, qr[d0], p1); }
            if (rel >= 0) { const int qrel = 32 * g + r32, kvb = 64 * rel + 4 * hi;
#pragma unroll
                for (int r = 0; r < 16; ++r) { const int kv = kvb + (r & 3) + 8 * (r >> 2); if (kv > qrel) p0[r] = -INFINITY; if (kv + 32 > qrel) p1[r] = -INFINITY; } }
            float s = 0.f;
#pragma unroll
            for (int r = 0; r < 16; ++r) { p0[r] = __builtin_amdgcn_exp2f(p0[r]); p1[r] = __builtin_amdgcn_exp2f(p1[r]); s += p0[r] + p1[r]; }
            l += s;
            u32x4 pw[4];
#pragma unroll
            for (int i = 0; i < 4; ++i) { pw[0][i] = cvtpk(p0[2 * i], p0[2 * i + 1]); pw[1][i] = cvtpk(p0[8 + 2 * i], p0[8 + 2 * i + 1]); pw[2][i] = cvtpk(p1[2 * i], p1[2 * i + 1]); pw[3][i] = cvtpk(p1[8 + 2 * i], p1[8 + 2 * i + 1]); }
#pragma unroll
            for (int db = 0; db < 4; ++db)
#pragma unroll
                for (int ks = 0; ks < 4; ++ks) { const s16x4 lo = vtr(vp + bo + (db * 4 + ks) * 1024), hh = vtr(vp + bo + (db * 4 + ks) * 1024 + 512);
                    const bf16x8 vf = (bf16x8){lo[0], lo[1], lo[2], lo[3], hh[0], hh[1], hh[2], hh[3]};
                    o[db] = AMFMA(__builtin_bit_cast(bf16x8, pw[ks]), vf, o[db]); }
        }
    }
#undef ADMA
    __syncthreads();
    l += __shfl_xor(l, 32);
    ALAS float* wsf = (ALAS float*)(lds + WSF_OFF) + wid * 64;
    if (hi == 0) wsf[r32] = l;
    float rli[16];
#pragma unroll
    for (int r = 0; r < 16; ++r) rli[r] = __builtin_amdgcn_rcpf(wsf[crow(r, hi)]);
    ALAS float* X = (ALAS float*)(lds + XOFF);
    if (sh == 1) {
#pragma unroll
        for (int db = 0; db < 4; ++db)
#pragma unroll
            for (int r = 0; r < 16; ++r) X[(32 * g + crow(r, hi)) * XROW + 32 * db + r32] = lam * o[db][r] * rli[r];
    }
    __syncthreads();
    if (sh == 0) {
#pragma unroll
        for (int db = 0; db < 4; ++db)
#pragma unroll
            for (int r = 0; r < 16; ++r) { ALAS float* xp = X + (32 * g + crow(r, hi)) * XROW + 32 * db + r32; *xp = o[db][r] * rli[r] - *xp; }
    }
    __syncthreads();
    {   const int row = 16 * wid + (lane >> 2), qd = lane & 3; const ALAS float* xs = X + row * XROW + 32 * qd;
        f32x4 v[8]; float ss = 0.f;
#pragma unroll
        for (int i = 0; i < 8; ++i) { v[i] = *(const ALAS f32x4*)(xs + 4 * i); ss += (v[i][0] * v[i][0] + v[i][1] * v[i][1]) + (v[i][2] * v[i][2] + v[i][3] * v[i][3]); }
        ss += __shfl_xor(ss, 1); ss += __shfl_xor(ss, 2);
        const float rstd = __builtin_amdgcn_rsqf(ss * (1.0f / 128.0f) + 1e-5f) * 0.8f;
        const size_t grow = rowbase + q0 + row;
        const bf16_t* zp = SZB + grow * 512 + 128 * h + 32 * qd; bf16_t* op = MIXED + grow * 1024 + 512 + 128 * h + 32 * qd; const float* sw = subw + 32 * qd;
#pragma unroll
        for (int i = 0; i < 4; ++i) { const bf16x8 z = *(const bf16x8*)(zp + 8 * i); const f32x4 w0 = *(const f32x4*)(sw + 8 * i), w1 = *(const f32x4*)(sw + 8 * i + 4);
            float y[8];
#pragma unroll
            for (int e = 0; e < 4; ++e) { y[e] = v[2 * i][e] * rstd * w0[e] * bf2f((unsigned short)z[e]); y[4 + e] = v[2 * i + 1][e] * rstd * w1[e] * bf2f((unsigned short)z[4 + e]); }
            u32x4 pk; pk.x = cvtpk(y[0], y[1]); pk.y = cvtpk(y[2], y[3]); pk.z = cvtpk(y[4], y[5]); pk.w = cvtpk(y[6], y[7]);
            *(u32x4*)(op + 8 * i) = pk; }
    }
}

__device__ __forceinline__ void gmlp_unit(ALAS unsigned char* lds, int b, int n, int hA, const bf16_t* Wsb, const bf16_t* VA, const float* SSQ, const float* sgw, const float* bs, const bf16_t* G, bf16_t* MIXED) {
    const int tid = threadIdx.x, lane = tid & 63, r32 = lane & 31, hi = lane >> 5;
    const int wid = __builtin_amdgcn_readfirstlane(tid >> 6), tb = wid & 3, ch = wid >> 2;
    const size_t R0 = (size_t)b * 2048 + 128 * n;
#pragma unroll
    for (int i = 0; i < 4; ++i) { const int cidx = tid + 512 * i, s = cidx >> 4, c8 = cidx & 15, c = 8 * c8;
        const bf16x8 v = *(const bf16x8*)(VA + (R0 + s) * 512 + 128 * hA + c);
        const f32x4 q = *(const f32x4*)(SSQ + ((R0 + s) * 4 + hA) * 4);
        const float rstd = __builtin_amdgcn_rsqf(((q[0] + q[1]) + (q[2] + q[3])) * (1.0f / 128.0f) + 1e-6f);
        const f32x4 w0 = *(const f32x4*)(sgw + 128 * hA + c), w1 = *(const f32x4*)(sgw + 128 * hA + c + 4);
        float y[8];
#pragma unroll
        for (int e = 0; e < 4; ++e) { y[e] = bf2f((unsigned short)v[e]) * rstd * w0[e]; y[4 + e] = bf2f((unsigned short)v[4 + e]) * rstd * w1[e]; }
        u32x4 pk; pk.x = cvtpk(y[0], y[1]); pk.y = cvtpk(y[2], y[3]); pk.z = cvtpk(y[4], y[5]); pk.w = cvtpk(y[6], y[7]);
        *(ALAS u32x4*)(lds + ((c >> 5) * 8 + (s >> 4)) * 1024 + (s & 15) * 64 + (c & 31) * 2) = pk; }
    __syncthreads();
    f32x16 acc[2]; acc[0] = f32x16{}; acc[1] = f32x16{};
    const bf16_t* wrow = Wsb + (size_t)hA * 16384 + (32 * tb + r32) * 128 + 8 * hi;
    const ALAS unsigned char* vp = lds + ((lane >> 4) & 1) * 32 + (lane & 3) * 8 + (8 * hi + ((lane & 15) >> 2)) * 64;
    const int nks = 2 * (tb + 1);
    for (int ks = 0; ks < nks; ++ks) { const bf16x8 a = *(const bf16x8*)(wrow + 16 * ks);
#pragma unroll
        for (int cbi = 0; cbi < 2; ++cbi) { const int cb = 2 * ch + cbi; const s16x4 lo = vtr(vp + (cb * 8 + ks) * 1024), hh = vtr(vp + (cb * 8 + ks) * 1024 + 256);
            const bf16x8 vf = (bf16x8){lo[0], lo[1], lo[2], lo[3], hh[0], hh[1], hh[2], hh[3]};
            acc[cbi] = AMFMA(a, vf, acc[cbi]); } }
#pragma unroll
    for (int cbi = 0; cbi < 2; ++cbi)
#pragma unroll
        for (int r = 0; r < 16; ++r) { const int t = 32 * tb + crow(r, hi), c = 32 * (2 * ch + cbi) + r32;
            const float gv = bf2f(G[(R0 + t) * 512 + 128 * hA + c]);
            MIXED[(R0 + t) * 1024 + 128 * hA + c] = (bf16_t)(cvtpk(gv * (acc[cbi][r] + bs[128 * hA + t]), 0.f) & 0xffffu); }
    __syncthreads();
}
#undef AMFMA
}
constexpr int NWAVES = 8;
constexpr int RING_OFF = 0, RING_BYTES = 131072;
constexpr int LDS_BYTES = 147456;
constexpr int MISC_OFF = LDS_BYTES - 512;
static_assert(att::ATT_LDS_END <= MISC_OFF, "attention LDS map");
constexpr int CW_BAR = 4096;
constexpr int NPHASE = 5;

__device__ __forceinline__ float wave_sum(float v) {
#pragma unroll
    for (int o = 1; o < 64; o <<= 1) v += __shfl_xor(v, o);
    return v;
}
__device__ __forceinline__ int virt_row(int n0) {
    if (n0 < 512) return 256 * (n0 >> 7) + (n0 & 127);
    if (n0 < 1024) return 1024 + (n0 - 512);
    if (n0 < 1536) { const int c = n0 - 1024; return 256 * (c >> 7) + 128 + (c & 127); }
    if (n0 < 2560) { const int isk = n0 >= 2048, c = n0 - (isk ? 2048 : 1536), head = c >> 6, bj = (c >> 5) & 1;
        return 256 * ((isk ? 8 : 6) + (head >> 2)) + 128 * bj + 32 * (head & 3); }
    return n0;
}
__device__ __forceinline__ void p0_transpose_item(const float* W, int K, int N, bf16* WT, bool virt, LAS float* scr, int item, int lane) {
    const int nblk = N / 32, kb = item / nblk, nb = item % nblk, k0 = 64 * kb, n0 = 32 * nb;
#pragma unroll 8
    for (int i = 0; i < 32; ++i) { const int kk = 2 * i + (lane >> 5); scr[kk * 33 + (lane & 31)] = W[(size_t)(k0 + kk) * N + n0 + (lane & 31)]; }
    LDS_WAIT(); asm volatile("" ::: "memory");
    const int c = lane & 7; const int vr0 = virt ? virt_row(n0) : n0;
#pragma unroll
    for (int j = 0; j < 4; ++j) { const int n = (lane >> 3) + 8 * j; const LAS float* s = scr + (8 * c) * 33 + n;
        v4u o; o.x = pk2(s[0 * 33], s[1 * 33]); o.y = pk2(s[2 * 33], s[3 * 33]); o.z = pk2(s[4 * 33], s[5 * 33]); o.w = pk2(s[6 * 33], s[7 * 33]);
        *(GAS v4u*)(WT + (size_t)(vr0 + n) * K + k0 + 8 * c) = o; }
    LDS_WAIT(); asm volatile("" ::: "memory");
}

struct Args { const void* in[18]; float* out; unsigned char* ws; int ph_lo, ph_hi, li, pad; };
__global__ void __launch_bounds__(NWAVES * 64, 2) mk_fwd(Args args) {
    extern __shared__ __attribute__((aligned(16))) unsigned char lds_raw[];
    LAS unsigned char* lds = (LAS unsigned char*)lds_raw;
    const int tid = threadIdx.x, lane = tid & 63, wave = __builtin_amdgcn_readfirstlane(tid >> 6);
    const int G = gridDim.x, bx = blockIdx.x; const int vcu = (G % 8 == 0) ? (bx % 8) * (G / 8) + bx / 8 : bx;
    volatile LAS unsigned* MISC = (volatile LAS unsigned*)(lds + MISC_OFF);
    for (int u = tid; u < (LDS_BYTES - MISC_OFF) / 4; u += NWAVES * 64) MISC[u] = 0u;
    __syncthreads();
    unsigned char* ws = args.ws;
    gu32* ctl = (gu32*)(ws + WS_CTL);
    const float* x = (const float*)args.in[0]; const float* cc = (const float*)args.in[1]; const int* pos = (const int*)args.in[2];
    const float* norm_w = (const float*)args.in[3]; const float* w_ada = (const float*)args.in[4]; const float* b_ada = (const float*)args.in[5];
    const float* w_in = (const float*)args.in[6]; const float* sgw = (const float*)args.in[7]; const float* w_s = (const float*)args.in[8]; const float* b_s = (const float*)args.in[9];
    const float* qnw = (const float*)args.in[10]; const float* knw = (const float*)args.in[11];
    const float* subw = (const float*)args.in[16]; const float* w_out = (const float*)args.in[17];
    bf16* WIN = (bf16*)(ws + WS_WIN); bf16* WOUT = (bf16*)(ws + WS_WOUT); bf16* WSB = (bf16*)(ws + WS_WSB);
    float* MOD = (float*)(ws + WS_MOD); float* LAMP = (float*)(ws + WS_LAM); float* MODP = (float*)(ws + WS_MODP); float* SSQ = (float*)(ws + WS_SSQ);
    bf16* H = (bf16*)(ws + WS_H); bf16* MIXED = (bf16*)(ws + WS_MIXED); bf16* GB = (bf16*)(ws + WS_G); bf16* VA = (bf16*)(ws + WS_VA);
    bf16* QB = (bf16*)(ws + WS_Q); bf16* KB = (bf16*)(ws + WS_K); bf16* VB = (bf16*)(ws + WS_VB); bf16* SZB = (bf16*)(ws + WS_SZB);
    const int lo = args.ph_lo, hi = args.ph_hi;
    XcdBarrier bar; bar.bar = (unsigned*)(ctl + CW_BAR) + args.li * XCD_BAR_WORDS; bar.x = 0; bar.st = nullptr;
    if (hi - lo > 1) bar = xcd_barrier_post((unsigned*)(ctl + CW_BAR) + args.li * XCD_BAR_WORDS, MISC + 8);
#define IN(k) (lo <= (k) && (k) < hi)
#define BOTH(k) (IN(k) && IN((k) + 1))

    if (IN(0)) {
        LAS float* scr = (LAS float*)(lds + RING_OFF + wave * 16384);
        const int gw = vcu * NWAVES + wave, NGW = G * NWAVES;
        constexpr int I_MOD = 16 * 48, I_WIN = 16 * (NIN / 32), I_WOUT = 16 * 32, I_WS = 64;
        for (int it = gw; it < I_MOD + I_WIN + I_WOUT + I_WS; it += NGW) {
            int r = it;
            if (r < I_MOD) { const int ks = r / 48, k0 = 64 * ks, j0 = 64 * (r % 48);
#pragma unroll
                for (int b = 0; b < 8; ++b) { const float v = cc[b * 1024 + k0 + lane]; scr[b * 64 + lane] = v * __builtin_amdgcn_rcpf(1.f + __expf(-v)); }
                LDS_WAIT(); asm volatile("" ::: "memory");
                float acc[8];
#pragma unroll
                for (int b = 0; b < 8; ++b) acc[b] = 0.f;
#pragma unroll 4
                for (int k = 0; k < 64; ++k) { const float w = w_ada[(size_t)(k0 + k) * 3072 + j0 + lane];
#pragma unroll
                    for (int b = 0; b < 8; ++b) acc[b] += scr[b * 64 + k] * w; }
                const float bias = (ks == 0) ? b_ada[j0 + lane] : 0.f;
#pragma unroll
                for (int b = 0; b < 8; ++b) MODP[(size_t)(ks * 8 + b) * 3072 + j0 + lane] = acc[b] + bias;
                LDS_WAIT(); asm volatile("" ::: "memory");
                continue; }
            r -= I_MOD;
            if (r < I_WIN) { p0_transpose_item(w_in, 1024, NIN, WIN, true, scr, r, lane); continue; } r -= I_WIN;
            if (r < I_WOUT) { p0_transpose_item(w_out, 1024, 1024, WOUT, false, scr, r, lane); continue; } r -= I_WOUT;
            {   const int idx = r * 1024 + lane * 16, t = (idx >> 7) & 127, s0 = idx & 127; const float* src = w_s + idx;
                v4u o0, o1; float v[16];
#pragma unroll
                for (int e = 0; e < 16; ++e) v[e] = (s0 + e <= t) ? src[e] : 0.f;
                o0.x = pk2(v[0], v[1]); o0.y = pk2(v[2], v[3]); o0.z = pk2(v[4], v[5]); o0.w = pk2(v[6], v[7]);
                o1.x = pk2(v[8], v[9]); o1.y = pk2(v[10], v[11]); o1.z = pk2(v[12], v[13]); o1.w = pk2(v[14], v[15]);
                *(GAS v4u*)(WSB + idx) = o0; *(GAS v4u*)(WSB + idx + 8) = o1; }
        }
        if (bx == 0 && wave == 0) {
            const float* lq1 = (const float*)args.in[12]; const float* lk1 = (const float*)args.in[13]; const float* lq2 = (const float*)args.in[14]; const float* lk2 = (const float*)args.in[15];
            const float a = wave_sum(lq1[lane] * lk1[lane]), b2 = wave_sum(lq2[lane] * lk2[lane]);
            if (lane == 0) LAMP[0] = __expf(a) - __expf(b2) + 0.2f;
        }
        if (BOTH(0)) xcd_barrier(bar);
    }
    if (IN(1)) {
        LAS float* g1s = (LAS float*)(lds + RING_OFF); LAS float* shs = g1s + 1024;
        for (int blk = vcu; blk < 256; blk += G) {
            const int b = blk >> 5;
            for (int k = tid; k < 1024; k += NWAVES * 64) { float sc = 0.f, sf = 0.f;
#pragma unroll
                for (int ks = 0; ks < 16; ++ks) { sf += MODP[(size_t)(ks * 8 + b) * 3072 + k]; sc += MODP[(size_t)(ks * 8 + b) * 3072 + 1024 + k]; }
                g1s[k] = norm_w[k] * (1.f + sc); shs[k] = sf; }
            if (tid < 96) { const int j = 96 * (blk & 31) + tid; float s = 0.f;
#pragma unroll
                for (int ks = 0; ks < 16; ++ks) s += MODP[(size_t)(ks * 8 + b) * 3072 + j];
                MOD[b * 3072 + j] = s; }
            __syncthreads();
#pragma unroll 2
            for (int i = 0; i < 8; ++i) { const size_t row = (size_t)blk * 64 + wave * 8 + i;
                const GAS f32x4* xr = (const GAS f32x4*)(x + row * 1024) + lane;
                f32x4 v[4]; float s = 0.f;
#pragma unroll
                for (int j = 0; j < 4; ++j) { v[j] = xr[64 * j]; s += (v[j].x * v[j].x + v[j].y * v[j].y) + (v[j].z * v[j].z + v[j].w * v[j].w); }
                const float rstd = __builtin_amdgcn_rsqf(wave_sum(s) * (1.f / 1024.f) + 1e-6f);
                GAS unsigned long long* o8 = (GAS unsigned long long*)(H + row * 1024) + lane;
#pragma unroll
                for (int j = 0; j < 4; ++j) { const f32x4 gg = *(const LAS f32x4*)(g1s + 4 * lane + 256 * j), ss = *(const LAS f32x4*)(shs + 4 * lane + 256 * j);
                    const f32x4 hv = v[j] * rstd * gg + ss;
                    o8[64 * j] = (unsigned long long)pk2(hv.x, hv.y) | ((unsigned long long)pk2(hv.z, hv.w) << 32); }
            }
            __syncthreads();
        }
        if (BOTH(1)) xcd_barrier(bar);
    }
    if (IN(2)) {
        pg8::Gemm g{H, WIN, MROWS, NIN, 1024}; pg8::StaticOrder S; S.init(MROWS, NIN, G, bx);
        pg8::Epi1 E{GB, VA, QB, KB, VB, SZB, SSQ, pos, qnw, knw};
        pg8::gemm_phase<pg8::Epi1, pg8::StaticOrder, true, true>(lds + RING_OFF, g, S, E);
        if (BOTH(2)) xcd_barrier(bar);
    }
    if (IN(3)) {
        const float lam = LAMP[0];
        for (int v = vcu; v < 256; v += G) {
            const int bh = v >> 3, s = v & 7;
            att::attn_unit(lds, bh >> 2, bh & 3, 15 - s, QB, KB, VB, SZB, MIXED, subw, lam);
            att::attn_unit(lds, bh >> 2, bh & 3, s, QB, KB, VB, SZB, MIXED, subw, lam);
#pragma unroll 1
            for (int i = 0; i < 2; ++i) { const int gi = 2 * v + i;
                att::gmlp_unit(lds, gi >> 6, (gi >> 2) & 15, gi & 3, WSB, VA, SSQ, sgw, b_s, GB, MIXED); }
        }
        if (BOTH(3)) xcd_barrier(bar);
    }
    if (IN(4)) {
        pg8::Gemm g{MIXED, WOUT, MROWS, 1024, 1024}; pg8::StaticOrder S; S.init(MROWS, 1024, G, bx);
        pg8::Epi2 E{x, MOD, args.out};
        pg8::gemm_phase<pg8::Epi2, pg8::StaticOrder, false, true>(lds + RING_OFF, g, S, E);
    }
#undef IN
#undef BOTH
}
#ifndef MK_N_LAUNCHES
#define MK_N_LAUNCHES 1
#endif
extern "C" void kernel_launch(void* const* d_in, const int* in_sizes, int n_in, void* d_out, int out_size, void* d_ws, size_t ws_size, hipStream_t stream) {
    static int grid = 0;
    if (grid == 0) {
        if (n_in != 18 || out_size != MROWS * DMODEL || ws_size < WS_END) { fprintf(stderr, "kernel_launch: unexpected sizes (n_in %d out %d ws %zu)\n", n_in, out_size, ws_size); grid = -1; return; }
        int dev = 0, cus = 0, per_cu = 0;
        if (hipGetDevice(&dev) != hipSuccess || hipDeviceGetAttribute(&cus, hipDeviceAttributeMultiprocessorCount, dev) != hipSuccess) { grid = -1; return; }
        if (hipFuncSetAttribute((const void*)mk_fwd, hipFuncAttributeMaxDynamicSharedMemorySize, LDS_BYTES) != hipSuccess) { fprintf(stderr, "kernel_launch: hipFuncSetAttribute failed\n"); grid = -1; return; }
        if (hipOccupancyMaxActiveBlocksPerMultiprocessor(&per_cu, (const void*)mk_fwd, NWAVES * 64, LDS_BYTES) != hipSuccess || per_cu < 1) { fprintf(stderr, "kernel_launch: occupancy query says %d blocks per CU\n", per_cu); }
        (void)hipGetLastError();
        grid = cus;
    }
    if (grid < 0) return;
    (void)hipMemsetAsync((char*)d_ws + WS_CTL, 0, CTL_ZERO_BYTES, stream);
    Args a{};
    for (int i = 0; i < 18; ++i) a.in[i] = d_in[i];
    a.out = (float*)d_out; a.ws = (unsigned char*)d_ws;
#if MK_N_LAUNCHES == 1
    a.ph_lo = 0; a.ph_hi = NPHASE; a.li = 0;
    hipLaunchKernelGGL(mk_fwd, dim3(grid), dim3(NWAVES * 64), LDS_BYTES, stream, a);
#else
    for (int p = 0; p < NPHASE; ++p) { a.ph_lo = p; a.ph_hi = p + 1; a.li = p; hipLaunchKernelGGL(mk_fwd, dim3(grid), dim3(NWAVES * 64), LDS_BYTES, stream, a); }
#endif
}
```

```cpp
#include <hip/hip_runtime.h>
#include <cstdio>
#include <cstdint>
constexpr int BATCH = 8, SEQ = 2048, DMODEL = 1024, MROWS = BATCH * SEQ, NIN = 3584;
constexpr float C2Q = 0.125f * 1.4426950408889634f;
constexpr size_t MiB = 1u << 20;
constexpr size_t WS_CTL = 0, CTL_ZERO_BYTES = 1 * MiB;
constexpr size_t WS_WIN = 1 * MiB;
constexpr size_t WS_WOUT = 8 * MiB;
constexpr size_t WS_WSB = 10 * MiB;
constexpr size_t WS_MOD = 10 * MiB + 256 * 1024;
constexpr size_t WS_LAM = 10 * MiB + 384 * 1024;
constexpr size_t WS_MODP = 10 * MiB + 512 * 1024;
constexpr size_t WS_SSQ = 12 * MiB;
constexpr size_t WS_H = 13 * MiB;
constexpr size_t WS_MIXED = WS_H;
constexpr size_t WS_G = 45 * MiB;
constexpr size_t WS_VA = 61 * MiB;
constexpr size_t WS_Q = 77 * MiB;
constexpr size_t WS_K = 93 * MiB;
constexpr size_t WS_VB = 109 * MiB;
constexpr size_t WS_SZB = 125 * MiB;
constexpr size_t WS_T0 = 141 * MiB;
constexpr size_t WS_T1 = 173 * MiB;
constexpr size_t WS_END = 205 * MiB;
#define GAS __attribute__((address_space(1)))
#define LAS __attribute__((address_space(3)))
typedef unsigned short bf16;
typedef unsigned v4u __attribute__((ext_vector_type(4)));
typedef float f32x4 __attribute__((ext_vector_type(4)));
typedef short bf16x8 __attribute__((ext_vector_type(8)));
typedef GAS unsigned gu32;
typedef GAS unsigned long long gu64;
#define RLX_AGENT __ATOMIC_RELAXED, __HIP_MEMORY_SCOPE_AGENT
#define LDS_WAIT() asm volatile("s_waitcnt lgkmcnt(0)" ::: "memory")
#define VM_WAIT() asm volatile("s_waitcnt vmcnt(0)" ::: "memory")
__device__ __forceinline__ unsigned long long rt() { return __builtin_amdgcn_s_memrealtime(); }
__device__ __forceinline__ unsigned f2bf(float f) { unsigned u = __builtin_bit_cast(unsigned, f); return (u + 0x7fffu + ((u >> 16) & 1u)) >> 16; }
__device__ __forceinline__ unsigned pk2(float lo, float hi) { return f2bf(lo) | (f2bf(hi) << 16); }
#define XB_TMO      128
#define XB_XCNT(j)  (256  + 64 * (j))
#define XB_XSUB(j)  (1280 + 64 * (j))
#define XB_XGEN(j)  (2304 + 64 * (j))
#define XB_TOP      3328
#define XB_TOPGEN   3392
#define XCD_BAR_WORDS 3456
#define XB_SPIN_CAP (1u << 18)

__device__ __forceinline__ unsigned xb_ld(unsigned* p)              { return __hip_atomic_load(p, __ATOMIC_RELAXED, __HIP_MEMORY_SCOPE_AGENT); }
__device__ __forceinline__ unsigned xb_add(unsigned* p, unsigned v) { return __hip_atomic_fetch_add(p, v, __ATOMIC_RELAXED, __HIP_MEMORY_SCOPE_AGENT); }
__device__ __forceinline__ unsigned xb_xcc_id() { return (unsigned)__builtin_amdgcn_s_getreg((3 << 11) | 20) & 0xFu; }
#define XB_SPIN(cond, bar) do { unsigned _sp = 0; while (cond) { __builtin_amdgcn_s_sleep(1); \
    if ((++_sp & 255u) == 0u) { if (xb_ld(&(bar)[XB_TMO])) break; if (_sp > XB_SPIN_CAP) { atomicAdd(&(bar)[XB_TMO], 1u); break; } } } } while (0)

struct XcdBarrier {
    unsigned* bar; unsigned x;
    volatile LAS unsigned* st;
};

__device__ __forceinline__ XcdBarrier xcd_barrier_post(unsigned* bar, volatile LAS unsigned* st) {
    XcdBarrier b; b.bar = bar; b.x = xb_xcc_id(); b.st = st;
    if (threadIdx.x == 0) (void)xb_add(&bar[XB_XCNT(b.x)], 1u);
    return b;
}
__device__ __forceinline__ void xcd_barrier_complete(unsigned* bar, unsigned x, unsigned& nloc, unsigned& nx) {
    const unsigned G = gridDim.x * gridDim.y * gridDim.z;
    unsigned sum, cnt, mine, sp = 0u;
    for (;;) {
        sum = 0u; cnt = 0u; mine = 0u;
#pragma unroll
        for (unsigned j = 0; j < 16; ++j) { const unsigned c = xb_ld(&bar[XB_XCNT(j)]); sum += c; cnt += (c > 0u) ? 1u : 0u; mine = (j == x) ? c : mine; }
        if (sum == G) break;
        __builtin_amdgcn_s_sleep(1);
        if ((++sp & 255u) == 0u) { if (xb_ld(&bar[XB_TMO])) break; if (sp > XB_SPIN_CAP) { atomicAdd(&bar[XB_TMO], 1u); break; } }
    }
    nloc = mine > 0u ? mine : 1u; nx = cnt > 0u ? cnt : 1u;
}

template <bool DRAINED = false>
__device__ __forceinline__ void xcd_barrier(const XcdBarrier& b) {
    if (!DRAINED) asm volatile("s_waitcnt vmcnt(0)" ::: "memory");
    __syncthreads();
    if (threadIdx.x == 0) {
        unsigned* bar = b.bar;
        __builtin_amdgcn_s_waitcnt(0);
        unsigned nloc = b.st[0], nx = b.st[1];
        if (nloc == 0u) { xcd_barrier_complete(bar, b.x, nloc, nx); b.st[0] = nloc; b.st[1] = nx; }
        const unsigned old = xb_add(&bar[XB_XSUB(b.x)], 1u);
        const unsigned gen = old / nloc;
        if (old + 1u == (gen + 1u) * nloc) {
            __builtin_amdgcn_fence(__ATOMIC_RELEASE, "agent");
            asm volatile("s_waitcnt vmcnt(0)" ::: "memory");
            const unsigned og = xb_add(&bar[XB_TOP], 1u);
            const unsigned tg = og / nx;
            if (og + 1u == (tg + 1u) * nx) xb_add(&bar[XB_TOPGEN], 1u);
            else XB_SPIN(xb_ld(&bar[XB_TOPGEN]) == tg, bar);
            __builtin_amdgcn_fence(__ATOMIC_ACQUIRE, "agent");
            xb_add(&bar[XB_XGEN(b.x)], 1u);
            asm volatile("s_waitcnt vmcnt(0)" ::: "memory");
        } else {
            XB_SPIN(xb_ld(&bar[XB_XGEN(b.x)]) == gen, bar);
            __builtin_amdgcn_fence(__ATOMIC_ACQUIRE, "agent");
            asm volatile("s_waitcnt vmcnt(0)" ::: "memory");
        }
    }
    __syncthreads();
}
namespace pg8 {
#define PG8_LAS __attribute__((address_space(3)))
typedef unsigned short bf16_t;
typedef short bf16x8 __attribute__((ext_vector_type(8)));
typedef float f32x4 __attribute__((ext_vector_type(4)));
typedef unsigned u32x4 __attribute__((ext_vector_type(4)));
constexpr int BM = 256, BK = 64, HALF = 128, HTB = HALF * BK * 2  , STAGE_BYTES = 8 * HTB, NXCD = 8, WGM = 8;

__host__ __device__ __forceinline__ int lds_byte(int r, int c) { const int st = (r >> 4) * 2 + (c >> 5), rr = r & 15, cc = c & 31, ob = rr * 64 + cc * 2; return st * 1024 + (ob ^ (((ob >> 9) & 1) << 5)); }
__host__ __device__ __forceinline__ void stage_rc(int b, int& R, int& C) { const int st = b / 1024, sb = b % 1024, swz = sb ^ (((sb >> 9) & 1) << 5); R = (st >> 1) * 16 + swz / 64; C = (st & 1) * 32 + (swz % 64) / 2; }
__host__ __device__ __forceinline__ int perm32(int rho) { const int n = rho >> 4, i = rho & 15; return 8 * (i >> 2) + 4 * n + (i & 3); }

struct Unit { int pm, pn, half; };
struct Gemm { const bf16_t* A; const bf16_t* Bt; int M, N, K; };

struct StaticOrder {
    int nM, nN, nwg, G, c;
    __host__ __device__ void init(int M, int N, int G_, int c_) { nM = M / BM; nN = N / BM; nwg = nM * nN; G = G_; c = c_; }
    __host__ __device__ bool next(int i, Unit& u) const {
        const long L = (long)i * G + c; if (L >= nwg) return false;
        int wgid = (int)L; { const int q = nwg / NXCD, r = nwg % NXCD, xcd = wgid % NXCD, off = wgid / NXCD; wgid = (xcd < r ? xcd * (q + 1) : r * (q + 1) + (xcd - r) * q) + off; }
        const int nig = WGM * nN, gid = wgid / nig, fm = gid * WGM, gsz = (nM - fm) < WGM ? (nM - fm) : WGM;
        u.pm = fm + ((wgid % nig) % gsz); u.pn = (wgid % nig) / gsz; u.half = -1; return true;
    }
    __device__ __forceinline__ void a_ready(const Unit&) const {}
    __device__ __forceinline__ void done(const Unit&) const {}
};

struct Order1 {
    StaticOrder so; bool split;
    __host__ __device__ void init(int M, int N, int G_, int c_) { so.init(M, N, G_, c_); split = (G_ == 256 && M == 16384 && N == 3584); }
    __host__ __device__ bool next(int i, Unit& u) const {
        if (!split || i < 3) return so.next(i, u);
        if (i > 3) return false;
        const int x = so.c & 7, j = so.c >> 3, q = j >> 3; u.pm = 8 * x + (j & 7); u.pn = 12 + (q >> 1); u.half = q & 1; return true;
    }
    __device__ __forceinline__ void a_ready(const Unit&) const {}
    __device__ __forceinline__ void done(const Unit&) const {}
};

__device__ __forceinline__ unsigned cvt_pk_bf16(float lo, float hi) { unsigned r; asm volatile("v_cvt_pk_bf16_f32 %0, %1, %2" : "=v"(r) : "v"(lo), "v"(hi)); return r; }
typedef float f32x2 __attribute__((ext_vector_type(2)));
__device__ __forceinline__ float silu_f(float z) { return z * __builtin_amdgcn_rcpf(1.f + __builtin_amdgcn_exp2f(-1.4426950408889634f * z)); }
__device__ __forceinline__ void store8(bf16_t* p, const f32x4& a, const f32x4& b) {
    u32x4 w; w.x = cvt_pk_bf16(a[0], a[1]); w.y = cvt_pk_bf16(a[2], a[3]); w.z = cvt_pk_bf16(b[0], b[1]); w.w = cvt_pk_bf16(b[2], b[3]); *(u32x4*)p = w; }
struct Epi1 {
    static constexpr bool PERM = true, AFTER_DRAIN = false;
    bf16_t *G, *VA, *Q, *K, *VB, *SZB; float* SSQ; const int* pos; const float *qnw, *knw;
    __device__ __forceinline__ void operator()(const f32x4 (&acc)[2][2][4][2], const Unit& u, int wr, int wc, int fr, int fq) const {
        const int row0 = u.pm * BM + wr * 64 + fr; const int p2 = u.pn >> 1, lo1 = u.pn & 1;
        const int pn = (p2 == 0) ? lo1 : (p2 == 1) ? 6 + lo1 : (p2 == 2) ? 4 + lo1 : (p2 == 3) ? 8 + lo1 : (p2 == 4) ? 2 + lo1 : (p2 == 5) ? 10 + lo1 : 12 + lo1;
        if (pn < 4) {
            bf16_t* base = G + (size_t)row0 * 512 + pn * 128 + wc * 32 + 8 * fq;
#pragma unroll
            for (int ai = 0; ai < 2; ++ai)
#pragma unroll
                for (int m = 0; m < 4; ++m) { f32x4 g0, g1;
#pragma unroll
                    for (int e = 0; e < 4; ++e) { g0[e] = acc[ai][0][m][0][e] * silu_f(acc[ai][1][m][0][e]); g1[e] = acc[ai][0][m][1][e] * silu_f(acc[ai][1][m][1][e]); }
                    store8(base + (size_t)(ai * HALF + m * 16) * 512, g0, g1); }
        } else if (pn < 6) {
#pragma unroll
            for (int ai = 0; ai < 2; ++ai)
#pragma unroll
                for (int m = 0; m < 4; ++m) { const int row = row0 + ai * HALF + m * 16;
#pragma unroll
                    for (int bj = 0; bj < 2; ++bj) { const f32x4 a = acc[ai][bj][m][0], b = acc[ai][bj][m][1];
                        store8(VA + (size_t)row * 512 + (pn - 4) * 256 + bj * 128 + wc * 32 + 8 * fq, a, b);
                        float s = (a[0] * a[0] + a[1] * a[1]) + (a[2] * a[2] + a[3] * a[3]) + (b[0] * b[0] + b[1] * b[1]) + (b[2] * b[2] + b[3] * b[3]);
                        s += __shfl_xor(s, 16); s += __shfl_xor(s, 32);
                        if (fq == 0) SSQ[((size_t)row * 4 + (pn - 4) * 2 + bj) * 4 + wc] = s; } }
        } else if (pn < 10) {
            const bool isq = pn < 8; const int head = 4 * (pn - (isq ? 6 : 8)) + wc;
            bf16_t* O = isq ? Q : K; const float* nw = isq ? qnw : knw; const float osc = isq ? C2Q : 1.0f;
            float w[2][2][4], invf[2][4];
#pragma unroll
            for (int n = 0; n < 2; ++n)
#pragma unroll
                for (int e = 0; e < 4; ++e) { const int i = 8 * fq + 4 * n + e; w[0][n][e] = nw[i]; w[1][n][e] = nw[32 + i];
                    invf[n][e] = __builtin_amdgcn_exp2f(-(float)i * 0.41524101186092029f) * 0.15915494309189535f; }
#pragma unroll
            for (int ai = 0; ai < 2; ++ai)
#pragma unroll
                for (int m = 0; m < 4; ++m) { const int row = row0 + ai * HALF + m * 16; const float p = (float)pos[row];
                    float ss = 0.f;
#pragma unroll
                    for (int bj = 0; bj < 2; ++bj)
#pragma unroll
                        for (int n = 0; n < 2; ++n) { const f32x4 a = acc[ai][bj][m][n]; ss += (a[0] * a[0] + a[1] * a[1]) + (a[2] * a[2] + a[3] * a[3]); }
                    ss += __shfl_xor(ss, 16); ss += __shfl_xor(ss, 32);
                    const float rstd = __builtin_amdgcn_rsqf(ss * (1.0f / 64.0f) + 1e-6f);
                    f32x4 o0[2], o1[2];
#pragma unroll
                    for (int n = 0; n < 2; ++n)
#pragma unroll
                        for (int e = 0; e < 4; ++e) { const float rev = __builtin_amdgcn_fractf(p * invf[n][e]);
                            const float sn = __builtin_amdgcn_sinf(rev), cs = __builtin_amdgcn_cosf(rev);
                            const float a = acc[ai][0][m][n][e] * rstd * w[0][n][e], b = acc[ai][1][m][n][e] * rstd * w[1][n][e];
                            o0[n][e] = (a * cs - b * sn) * osc; o1[n][e] = (b * cs + a * sn) * osc; }
                    if (isq) { bf16_t* op = O + (size_t)row * 512 + 64 * head + 8 * fq; store8(op, o0[0], o0[1]); store8(op + 32, o1[0], o1[1]); }
                    else {
                        const int bb = row >> 11, sq = row & 2047; bf16_t* op = O + ((size_t)((bb * 8 + head) * 32 + (sq >> 6)) << 12) + fq * 512 + (sq & 63) * 8;
                        store8(op, o0[0], o0[1]); store8(op + 4 * 512, o1[0], o1[1]); } }
        } else {
            const bool sil = pn >= 12; bf16_t* O = sil ? SZB : VB; const int cbase = (pn - (sil ? 12 : 10)) * 256 + wc * 32 + 8 * fq + (u.half > 0 ? 128 : 0);
            const int nbj = (u.half >= 0) ? 1 : 2;
#pragma unroll
            for (int ai = 0; ai < 2; ++ai)
#pragma unroll
                for (int m = 0; m < 4; ++m) { const int row = row0 + ai * HALF + m * 16;
#pragma unroll
                    for (int bj = 0; bj < 2; ++bj) { if (bj >= nbj) continue; f32x4 a = acc[ai][bj][m][0], b = acc[ai][bj][m][1];
                        if (sil) {
#pragma unroll
                            for (int e = 0; e < 4; ++e) { a[e] = silu_f(a[e]); b[e] = silu_f(b[e]); } }
                        if (sil) store8(O + (size_t)row * 512 + cbase + bj * 128, a, b);
                        else {
                            const int bb = row >> 11, sq = row & 2047, hh = 2 * (pn - 10) + bj;
                            store8(O + ((size_t)((bb * 4 + hh) * 32 + (sq >> 6)) << 13) + (wc * 4 + ((sq & 63) >> 4)) * 512 + (sq & 15) * 32 + 8 * fq, a, b); } } }
        }
    }
};
struct Epi2 {
    static constexpr bool PERM = true, AFTER_DRAIN = false;
    const float* x; const float* mod; float* out;
    __device__ __forceinline__ void operator()(const f32x4 (&acc)[2][2][4][2], const Unit& u, int wr, int wc, int fr, int fq) const {
        const int row0 = u.pm * BM + wr * 64 + fr; const int b = (u.pm * BM) >> 11; const int col0 = u.pn * BM + wc * 32 + 8 * fq;
#pragma unroll
        for (int bj = 0; bj < 2; ++bj) { const f32x4 g0 = *(const f32x4*)(mod + b * 3072 + 2048 + col0 + bj * HALF), g1 = *(const f32x4*)(mod + b * 3072 + 2048 + col0 + bj * HALF + 4);
#pragma unroll
            for (int ai = 0; ai < 2; ++ai)
#pragma unroll
                for (int m = 0; m < 4; ++m) { const size_t off = (size_t)(row0 + ai * HALF + m * 16) * 1024 + col0 + bj * HALF;
                    const f32x4 x0 = *(const f32x4*)(x + off), x1 = *(const f32x4*)(x + off + 4);
                    *(f32x4*)(out + off) = x0 + g0 * acc[ai][bj][m][0]; *(f32x4*)(out + off + 4) = x1 + g1 * acc[ai][bj][m][1];
                    if (m & 1) asm volatile("" ::: "memory"); } }
    }
};
struct EpiNull {
    static constexpr bool PERM = true, AFTER_DRAIN = false;
    __device__ __forceinline__ void operator()(const f32x4 (&acc)[2][2][4][2], const Unit& u, int wr, int wc, int fr, int fq) const {
#pragma unroll
        for (int ai = 0; ai < 2; ++ai)
#pragma unroll
            for (int bj = 0; bj < 2; ++bj)
#pragma unroll
                for (int m = 0; m < 4; ++m)
#pragma unroll
                    for (int n = 0; n < 2; ++n) asm volatile("" :: "v"(acc[ai][bj][m][n]));
    }
};
struct Epi2x2 {
    static constexpr bool PERM = true, AFTER_DRAIN = false;
    Epi2 e;
    __device__ __forceinline__ void operator()(const f32x4 (&acc)[2][2][4][2], const Unit& u, int wr, int wc, int fr, int fq) const { e(acc, u, wr, wc, fr, fq); asm volatile("" ::: "memory"); e(acc, u, wr, wc, fr, fq); }
};
template <class Epi, class Sched, bool ALIGN_EPI = false, bool SP2 = false>
__device__ __forceinline__ void gemm_phase(PG8_LAS unsigned char* lds, const Gemm g, const Sched& S, const Epi& E) {
    int tid_ = threadIdx.x; asm volatile("" : "+v"(tid_));
    const int tid = tid_, wid = __builtin_amdgcn_readfirstlane(tid >> 6), lane = tid & 63, wr = wid >> 2, wc = wid & 3, fr = lane & 15, fq = lane >> 4;
    const int K = g.K, nt = K / BK;
    unsigned voffA[2], voffB[2];
#pragma unroll
    for (int i = 0; i < 2; ++i) { int R, C; stage_rc(tid * 16 + i * 8192, R, C); const int Rb = Epi::PERM ? ((R & ~31) + perm32(R & 31)) : R;
        voffA[i] = (unsigned)(R * K + C) * 2u; voffB[i] = (unsigned)(Rb * K + C) * 2u; }
    const size_t kstep = (size_t)(BK * 2);
    const size_t hstep = (size_t)HALF * K * 2;
    const size_t tstep = 2 * hstep;
    const unsigned ldsw = (unsigned)wid * 1024u;
    const int aoff = lds_byte(wr * 64 + fr, fq * 8), boff = lds_byte(wc * 32 + fr, fq * 8);
#define PG8_SA(b, h) (((b) * 2 + (h)) * HTB)
#define PG8_SB(b, h) ((4 + (b) * 2 + (h)) * HTB)
#define PG8_STAGE(bufoff, gbase, voff) do { _Pragma("unroll") for (int _i = 0; _i < 2; ++_i) \
        __builtin_amdgcn_global_load_lds((const unsigned*)((const char*)(gbase) + (voff)[_i]), (PG8_LAS unsigned*)(lds + (bufoff) + ldsw + _i * 8192), 16, 0, 0); } while (0)
#define PG8_LDA(dst, b, h) do { _Pragma("unroll") for (int m = 0; m < 4; ++m) _Pragma("unroll") for (int k = 0; k < 2; ++k) dst[m][k] = *(const PG8_LAS bf16x8*)(lds + PG8_SA(b, h) + aoff + m * 2048 + k * 1024); } while (0)
#define PG8_LDB(dst, b, h) do { _Pragma("unroll") for (int n = 0; n < 2; ++n) _Pragma("unroll") for (int k = 0; k < 2; ++k) dst[n][k] = *(const PG8_LAS bf16x8*)(lds + PG8_SB(b, h) + boff + n * 2048 + k * 1024); } while (0)
#define PG8_MMA(ai, bj, At, Bt) do { __builtin_amdgcn_s_setprio(1); _Pragma("unroll") for (int m = 0; m < 4; ++m) _Pragma("unroll") for (int n = 0; n < 2; ++n) _Pragma("unroll") for (int k = 0; k < 2; ++k) \
        acc[ai][bj][m][n] = __builtin_amdgcn_mfma_f32_16x16x32_bf16(Bt[n][k], At[m][k], acc[ai][bj][m][n], 0, 0, 0); __builtin_amdgcn_s_setprio(0); } while (0)
#define PG8_WAIT_V(n) asm volatile("s_waitcnt vmcnt(" #n ")" ::: "memory")
#define PG8_WAIT_L(n) asm volatile("s_waitcnt lgkmcnt(" #n ")" ::: "memory")
#define PG8_BAR __builtin_amdgcn_s_barrier()
#define PG8_SCHED __builtin_amdgcn_sched_barrier(0)
    Unit cur, nxt; int ui = 0;
    if (!S.next(0, cur)) return;
    f32x4 acc[2][2][4][2];
#pragma unroll
    for (int a = 0; a < 2; ++a)
#pragma unroll
        for (int b = 0; b < 2; ++b)
#pragma unroll
            for (int m = 0; m < 4; ++m)
#pragma unroll
                for (int n = 0; n < 2; ++n) acc[a][b][m][n] = (f32x4){0.f, 0.f, 0.f, 0.f};
    bf16x8 At[4][2], B0[2][2], B1[2][2];
    const char* cA = (const char*)g.A + (size_t)cur.pm * tstep; const char* cB = (const char*)g.Bt + (size_t)cur.pn * tstep + (cur.half > 0 ? hstep : 0);
    S.a_ready(cur);
    if constexpr (SP2) {
        PG8_STAGE(PG8_SB(0, 0), cB, voffB); PG8_STAGE(PG8_SB(0, 1), cB + hstep, voffB); PG8_STAGE(PG8_SA(0, 0), cA, voffA); PG8_STAGE(PG8_SA(0, 1), cA + hstep, voffA);
        if (wr == 1) PG8_BAR;
        PG8_WAIT_V(2); PG8_BAR;
        PG8_STAGE(PG8_SB(1, 0), cB + kstep, voffB); PG8_STAGE(PG8_SA(1, 0), cA + kstep, voffA); PG8_STAGE(PG8_SB(1, 1), cB + hstep + kstep, voffB);
        PG8_WAIT_V(6); PG8_BAR;
    } else {
        PG8_STAGE(PG8_SB(0, 0), cB, voffB); PG8_STAGE(PG8_SA(0, 0), cA, voffA); PG8_STAGE(PG8_SB(0, 1), cB + hstep, voffB); PG8_STAGE(PG8_SA(0, 1), cA + hstep, voffA);
        if (wr == 1) PG8_BAR;
        PG8_WAIT_V(4); PG8_BAR;
        PG8_STAGE(PG8_SB(1, 0), cB + kstep, voffB); PG8_STAGE(PG8_SA(1, 0), cA + kstep, voffA); PG8_STAGE(PG8_SB(1, 1), cB + hstep + kstep, voffB);
        PG8_WAIT_V(6); PG8_BAR;
    }
    for (;;) {
        const bool has_next = S.next(ui + 1, nxt);
        const char* nA = has_next ? (const char*)g.A + (size_t)nxt.pm * tstep : cA; const char* nB = has_next ? (const char*)g.Bt + (size_t)nxt.pn * tstep + (nxt.half > 0 ? hstep : 0) : cB;
        const bool fullu = cur.half < 0;
        for (int t = 0; t < nt; t += 2) {
            const bool last = (t == nt - 2);
            const char* a1 = cA + (size_t)(t + 1) * kstep;
            const char* a2 = last ? nA : cA + (size_t)(t + 2) * kstep; const char* b2 = last ? nB : cB + (size_t)(t + 2) * kstep;
            const char* a3 = a2 + kstep; const char* b3 = b2 + kstep;
            if (last && has_next) S.a_ready(nxt);
            if constexpr (SP2) {
            PG8_LDB(B0, 0, 0); PG8_LDB(B1, 0, 1); PG8_SCHED; PG8_LDA(At, 0, 0); PG8_STAGE(PG8_SA(1, 1), a1 + hstep, voffA);
            PG8_WAIT_V(8); PG8_WAIT_L(0); PG8_BAR; PG8_MMA(0, 0, At, B0); PG8_MMA(0, 1, At, B1); PG8_BAR; PG8_SCHED;
            PG8_LDA(At, 0, 1); PG8_STAGE(PG8_SB(0, 0), b2, voffB); PG8_STAGE(PG8_SB(0, 1), b2 + hstep, voffB); PG8_STAGE(PG8_SA(0, 0), a2, voffA);
            PG8_WAIT_V(8); PG8_WAIT_L(0); PG8_BAR; PG8_MMA(1, 0, At, B0); PG8_MMA(1, 1, At, B1); PG8_BAR; PG8_SCHED;
            PG8_LDB(B0, 1, 0); PG8_LDB(B1, 1, 1); PG8_SCHED; PG8_LDA(At, 1, 0); PG8_STAGE(PG8_SA(0, 1), a2 + hstep, voffA);
            PG8_WAIT_V(8); PG8_WAIT_L(0); PG8_BAR; PG8_MMA(0, 0, At, B0); PG8_MMA(0, 1, At, B1); PG8_BAR; PG8_SCHED;
            PG8_LDA(At, 1, 1); PG8_STAGE(PG8_SB(1, 0), b3, voffB); PG8_STAGE(PG8_SB(1, 1), b3 + hstep, voffB); PG8_STAGE(PG8_SA(1, 0), a3, voffA);
            PG8_WAIT_V(8); PG8_WAIT_L(0); PG8_BAR; PG8_MMA(1, 0, At, B0); PG8_MMA(1, 1, At, B1); PG8_BAR; PG8_SCHED;
            } else {
            PG8_LDB(B0, 0, 0); PG8_SCHED; PG8_LDA(At, 0, 0); PG8_STAGE(PG8_SA(1, 1), a1 + hstep, voffA);
            PG8_WAIT_L(8); PG8_BAR; PG8_WAIT_L(0); PG8_MMA(0, 0, At, B0); PG8_BAR; PG8_SCHED;
            PG8_LDB(B1, 0, 1); PG8_STAGE(PG8_SB(0, 0), b2, voffB);
            PG8_BAR; PG8_WAIT_L(0); PG8_MMA(0, 1, At, B1); PG8_BAR;
            PG8_LDA(At, 0, 1); PG8_STAGE(PG8_SA(0, 0), a2, voffA);
            PG8_BAR; PG8_WAIT_L(0); PG8_MMA(1, 0, At, B0); PG8_BAR; PG8_SCHED;
            PG8_STAGE(PG8_SB(0, 1), b2 + hstep, voffB);
            PG8_WAIT_V(6); PG8_BAR; PG8_MMA(1, 1, At, B1); PG8_BAR;
            PG8_LDB(B0, 1, 0); PG8_SCHED; PG8_LDA(At, 1, 0); PG8_STAGE(PG8_SA(0, 1), a2 + hstep, voffA);
            PG8_WAIT_L(8); PG8_BAR; PG8_WAIT_L(0); PG8_MMA(0, 0, At, B0); PG8_BAR; PG8_SCHED;
            PG8_LDB(B1, 1, 1); PG8_STAGE(PG8_SB(1, 0), b3, voffB);
            PG8_BAR; PG8_WAIT_L(0); PG8_MMA(0, 1, At, B1); PG8_BAR;
            PG8_LDA(At, 1, 1); PG8_STAGE(PG8_SA(1, 0), a3, voffA);
            PG8_BAR; PG8_WAIT_L(0); PG8_MMA(1, 0, At, B0); PG8_BAR; PG8_SCHED;
            PG8_STAGE(PG8_SB(1, 1), b3 + hstep, voffB);
            PG8_WAIT_V(6); PG8_BAR; PG8_MMA(1, 1, At, B1); PG8_BAR;
            }
        }
        if constexpr (ALIGN_EPI) { if (wr == 0) PG8_BAR; }
        if constexpr (!Epi::AFTER_DRAIN) { E(acc, cur, wr, wc, fr, fq); S.done(cur); }
        if (!has_next) break;
#pragma unroll
        for (int a = 0; a < 2; ++a)
#pragma unroll
            for (int b = 0; b < 2; ++b)
#pragma unroll
                for (int m = 0; m < 4; ++m)
#pragma unroll
                    for (int n = 0; n < 2; ++n) acc[a][b][m][n] = (f32x4){0.f, 0.f, 0.f, 0.f};
        cur = nxt; cA = nA; cB = nB; ++ui;
        if constexpr (ALIGN_EPI) { if (wr == 1) PG8_BAR; }
    }
    PG8_WAIT_V(0);
    if constexpr (!ALIGN_EPI) { if (wr == 0) PG8_BAR; }
    PG8_BAR;
    if constexpr (Epi::AFTER_DRAIN) { E.fused(acc, cur, wr, wc, fr, fq, lds, wid, lane); S.done(cur); }
#undef PG8_SA
#undef PG8_SB
#undef PG8_STAGE
#undef PG8_LDA
#undef PG8_LDB
#undef PG8_MMA
#undef PG8_WAIT_V
#undef PG8_WAIT_L
#undef PG8_BAR
#undef PG8_SCHED
}
}
namespace att {
typedef unsigned short bf16_t;
typedef short bf16x8 __attribute__((ext_vector_type(8)));
typedef short s16x4 __attribute__((ext_vector_type(4)));
typedef short v4i16_t __attribute__((ext_vector_type(4)));
typedef float f32x4 __attribute__((ext_vector_type(4)));
typedef float f32x16 __attribute__((ext_vector_type(16)));
typedef unsigned u32x4 __attribute__((ext_vector_type(4)));
#define ALAS __attribute__((address_space(3)))
constexpr int KOFF0 = 0, KOFF1 = 8192, VOFF = 16384, BUFB = 32768;
constexpr int XOFF = 65536, XROW = 132;
constexpr int WSF_OFF = XOFF + 128 * XROW * 4;
constexpr int ATT_LDS_END = WSF_OFF + 8 * 256;
__device__ __forceinline__ int crow(int r, int hi) { return (r & 3) + 8 * (r >> 2) + 4 * hi; }
__device__ __forceinline__ unsigned cvtpk(float lo, float hi) { typedef float f2 __attribute__((ext_vector_type(2))); typedef __bf16 b2 __attribute__((ext_vector_type(2))); f2 v = {lo, hi}; b2 b = __builtin_convertvector(v, b2); return __builtin_bit_cast(unsigned, b); }
__device__ __forceinline__ s16x4 vtr(const ALAS unsigned char* p) { return __builtin_bit_cast(s16x4, __builtin_amdgcn_ds_read_tr16_b64_v4i16((ALAS v4i16_t*)p)); }
__device__ __forceinline__ float bf2f(unsigned short h) { return __uint_as_float(((unsigned)h) << 16); }
__device__ __forceinline__ void st16_wt(void* p, u32x4 v) { asm volatile("global_store_dwordx4 %0, %1, off sc1\n\ts_nop 1" :: "v"(p), "v"(v) : "memory"); }
#define AMFMA(a, b, c) __builtin_amdgcn_mfma_f32_32x32x16_bf16(a, b, c, 0, 0, 0)
#define LBAR() asm volatile("s_waitcnt lgkmcnt(0)\n\ts_barrier" ::: "memory")

constexpr int GM_TOFF = 32768, GM_TROW = 132;
struct GmLoads { bf16x8 vv[4]; f32x4 qq[4], w0[4], w1[4]; bf16x8 af[8]; bf16x8 gv[4]; float bsv[16]; };
__device__ __forceinline__ void gm_load(GmLoads& L, int tid, int gi, const bf16_t* Wsb, const bf16_t* VA, const float* SSQ, const float* sgw, const bf16_t* G, const float* bs) {
    const int b = gi >> 6, n = (gi >> 2) & 15, hA = gi & 3; const size_t R0 = (size_t)b * 2048 + 128 * n;
    const int lane = tid & 63, r32 = lane & 31, hi = lane >> 5, tb = (tid >> 6) & 3;
#pragma unroll
    for (int i = 0; i < 4; ++i) { const int cidx = tid + 512 * i, s = cidx >> 4, c = 8 * (cidx & 15);
        L.vv[i] = *(const bf16x8*)(VA + (R0 + s) * 512 + 128 * hA + c); L.qq[i] = *(const f32x4*)(SSQ + ((R0 + s) * 4 + hA) * 4);
        L.w0[i] = *(const f32x4*)(sgw + 128 * hA + c); L.w1[i] = *(const f32x4*)(sgw + 128 * hA + c + 4);
        L.gv[i] = *(const bf16x8*)(G + (R0 + s) * 512 + 128 * hA + c); }
    const bf16_t* wrow = Wsb + (size_t)hA * 16384 + (32 * tb + r32) * 128 + 8 * hi;
#pragma unroll
    for (int ks = 0; ks < 8; ++ks) L.af[ks] = (ks < 2 * (tb + 1)) ? *(const bf16x8*)(wrow + 16 * ks) : (bf16x8){0, 0, 0, 0, 0, 0, 0, 0};
#pragma unroll
    for (int r = 0; r < 16; ++r) L.bsv[r] = bs[128 * hA + 32 * tb + crow(r, hi)];
}
__device__ __forceinline__ void gm_stage(ALAS unsigned char* lds, const GmLoads& L, int tid) {
#pragma unroll
    for (int i = 0; i < 4; ++i) { const int cidx = tid + 512 * i, s = cidx >> 4, c = 8 * (cidx & 15);
        const float rstd = __builtin_amdgcn_rsqf(((L.qq[i][0] + L.qq[i][1]) + (L.qq[i][2] + L.qq[i][3])) * (1.0f / 128.0f) + 1e-6f);
        float y[8];
#pragma unroll
        for (int e = 0; e < 4; ++e) { y[e] = bf2f((unsigned short)L.vv[i][e]) * rstd * L.w0[i][e]; y[4 + e] = bf2f((unsigned short)L.vv[i][4 + e]) * rstd * L.w1[i][e]; }
        u32x4 pk; pk.x = cvtpk(y[0], y[1]); pk.y = cvtpk(y[2], y[3]); pk.z = cvtpk(y[4], y[5]); pk.w = cvtpk(y[6], y[7]);
        *(ALAS u32x4*)(lds + ((c >> 5) * 8 + (s >> 4)) * 1024 + (s & 15) * 64 + (c & 31) * 2) = pk; }
}
__device__ __forceinline__ void gm_mma(ALAS unsigned char* lds, const GmLoads& L, int tid, int gi, const float* bs) {
    const int lane = tid & 63, r32 = lane & 31, hi = lane >> 5, tb = (tid >> 6) & 3, ch = tid >> 8, hA = gi & 3;
    f32x16 acc[2]; acc[0] = f32x16{}; acc[1] = f32x16{};
    const ALAS unsigned char* vp = lds + ((lane >> 4) & 1) * 32 + (lane & 3) * 8 + (8 * hi + ((lane & 15) >> 2)) * 64;
#pragma unroll
    for (int ks = 0; ks < 8; ++ks) { if (ks < 2 * (tb + 1)) {
#pragma unroll
        for (int cbi = 0; cbi < 2; ++cbi) { const int cb = 2 * ch + cbi; const s16x4 lo = vtr(vp + (cb * 8 + ks) * 1024), hh = vtr(vp + (cb * 8 + ks) * 1024 + 256);
            const bf16x8 vf = (bf16x8){lo[0], lo[1], lo[2], lo[3], hh[0], hh[1], hh[2], hh[3]};
            acc[cbi] = AMFMA(L.af[ks], vf, acc[cbi]); } } }
    ALAS float* T = (ALAS float*)(lds + GM_TOFF);
#pragma unroll
    for (int r = 0; r < 16; ++r) { const int t = 32 * tb + crow(r, hi); const float bias = L.bsv[r];
        T[t * GM_TROW + 32 * (2 * ch) + r32] = acc[0][r] + bias; T[t * GM_TROW + 32 * (2 * ch + 1) + r32] = acc[1][r] + bias; }
}
__device__ __forceinline__ void gm_epi(ALAS unsigned char* lds, const GmLoads& L, int tid, int gi, bf16_t* MIXED) {
    const int b = gi >> 6, n = (gi >> 2) & 15, hA = gi & 3; const size_t R0 = (size_t)b * 2048 + 128 * n;
    const ALAS float* T = (const ALAS float*)(lds + GM_TOFF);
#pragma unroll
    for (int i = 0; i < 4; ++i) { const int cidx = tid + 512 * i, t = cidx >> 4, c = 8 * (cidx & 15);
        const f32x4 m0 = *(const ALAS f32x4*)(T + t * GM_TROW + c), m1 = *(const ALAS f32x4*)(T + t * GM_TROW + c + 4);
        float y[8];
#pragma unroll
        for (int e = 0; e < 4; ++e) { y[e] = bf2f((unsigned short)L.gv[i][e]) * m0[e]; y[4 + e] = bf2f((unsigned short)L.gv[i][4 + e]) * m1[e]; }
        u32x4 pk; pk.x = cvtpk(y[0], y[1]); pk.y = cvtpk(y[2], y[3]); pk.z = cvtpk(y[4], y[5]); pk.w = cvtpk(y[6], y[7]);
        *(u32x4*)(MIXED + (R0 + t) * 1024 + 128 * hA + c) = pk; }
}
__device__ __forceinline__ void gmlp_pair(ALAS unsigned char* lds, int gi0, int gi1, const bf16_t* Wsb, const bf16_t* VA, const float* SSQ, const float* sgw, const float* bs, const bf16_t* G, bf16_t* MIXED) {
    int tid = threadIdx.x; asm volatile("" : "+v"(tid));
    GmLoads A, B;
    gm_load(A, tid, gi0, Wsb, VA, SSQ, sgw, G, bs);
    gm_stage(lds, A, tid);
    LBAR();
    gm_load(B, tid, gi1, Wsb, VA, SSQ, sgw, G, bs);
    gm_mma(lds, A, tid, gi0, bs);
    LBAR();
    gm_epi(lds, A, tid, gi0, MIXED);
    gm_stage(lds, B, tid);
    LBAR();
    gm_mma(lds, B, tid, gi1, bs);
    LBAR();
    gm_epi(lds, B, tid, gi1, MIXED);
    LBAR();
}
#undef AMFMA
}
namespace att2 {
using att::bf16_t; using att::bf16x8; using att::s16x4; using att::f32x4; using att::f32x16; using att::u32x4; using att::crow; using att::cvtpk; using att::vtr; using att::bf2f;
constexpr int SLOTB = 16384, NSLOT = 3;
constexpr int LDS_K = 0, LDS_V = NSLOT * SLOTB, RING_END = 2 * NSLOT * SLOTB;
constexpr int XOFF = LDS_V + SLOTB, XROW = 132;
constexpr int WSF_OFF = XOFF + 128 * XROW * 4, ATT2_LDS_END = WSF_OFF + 8 * 256;
#define SBAR() __builtin_amdgcn_sched_barrier(0)
#define PIN(x) asm volatile("" : "+v"(x))
#define MFMA32(a, b, c) __builtin_amdgcn_mfma_f32_32x32x16_bf16(a, b, c, 0, 0, 0)
#define WAIT_BAR(N) asm volatile("s_waitcnt vmcnt(" #N ") lgkmcnt(0)\n\ts_barrier" ::: "memory")
__device__ __forceinline__ void glds16(unsigned voff, const void* sbase, unsigned lds_dst) { unsigned keep;
    asm volatile("s_mov_b32 %0, m0\n\ts_mov_b32 m0, %3\n\ts_nop 0\n\tglobal_load_lds_dwordx4 %1, %2\n\ts_mov_b32 m0, %0" : "=&s"(keep) : "v"(voff), "s"(sbase), "s"(lds_dst) : "memory"); }
typedef const ALAS unsigned char* lptr;
__device__ __forceinline__ void cmask(f32x16& p0, f32x16& p1, int rel, int qrel, int hi) {
    int thr = qrel - 64 * rel - 4 * hi; asm volatile("" : "+v"(thr));
#pragma unroll
    for (int r = 0; r < 16; ++r) { const int c = (r & 3) + 8 * (r >> 2); if (c > thr) p0[r] = -INFINITY; if (c + 32 > thr) p1[r] = -INFINITY; }
}

__device__ __forceinline__ void attn_pair(ALAS unsigned char* lds, unsigned lds0, int b, int h, int qbA, int qbB, const bf16_t* Q, const bf16_t* __restrict__ K, const bf16_t* __restrict__ V, const bf16_t* SZB, bf16_t* MIXED, const float* subw, float lam) {
    int tid_ = threadIdx.x; asm volatile("" : "+v"(tid_));
    const int tid = tid_, lane = tid & 63, r32 = lane & 31, hi = lane >> 5;
    const int wid = __builtin_amdgcn_readfirstlane(tid >> 6), g = wid & 3, sh = wid >> 2;
    const size_t rowbase = (size_t)b * 2048;
    const bf16_t* kbase = K + ((size_t)((b * 8 + 2 * h) * 32) << 12);
    const bf16_t* vbase = V + ((size_t)((b * 4 + h) * 32) << 13);
    const unsigned koff = (unsigned)(wid * 1024 + lane * 16);
    const unsigned voff = (unsigned)(((wid >> 2) * 4 + (wid & 3)) * 1024 + lane * 16);
    const unsigned kdst = lds0 + LDS_K + wid * 1024, vdst = lds0 + LDS_V + ((wid >> 2) * 4 + (wid & 3)) * 1024;
#define DMA_K(t, slot) do { const bf16_t* s_ = kbase + ((size_t)(t) << 12); glds16(koff, s_, (unsigned)__builtin_amdgcn_readfirstlane(kdst + (slot))); glds16(koff, s_ + (32 << 12), (unsigned)__builtin_amdgcn_readfirstlane(kdst + (slot) + 8192)); } while (0)
#define DMA_V(t, slot) do { const bf16_t* s_ = vbase + ((size_t)(t) << 13); glds16(voff, s_, (unsigned)__builtin_amdgcn_readfirstlane(vdst + (slot))); glds16(voff, s_ + 4096, (unsigned)__builtin_amdgcn_readfirstlane(vdst + (slot) + 8192)); } while (0)
    const lptr kp0 = lds + LDS_K + sh * 8192 + hi * 1024 + r32 * 16;
    const lptr vp0 = lds + LDS_V + ((lane >> 4) & 1) * 32 + (lane & 3) * 8 + (4 * hi + ((lane & 15) >> 2)) * 64;
#define ISSUE(qb_, qq_) do { DMA_K(0, 0); DMA_V(0, 0); DMA_K(1, SLOTB); \
        const bf16_t* Qw_ = Q + (rowbase + (qb_) * 128 + 32 * g + r32) * 512 + 64 * (2 * h + sh); \
        _Pragma("unroll") for (int d0 = 0; d0 < 4; ++d0) qq_[d0] = *(const bf16x8*)(Qw_ + 16 * d0 + 8 * hi); \
        if ((qb_) > 0) DMA_K(2, 2 * SLOTB); } while (0)
    bf16x8 qr[4], qn[4];
    ISSUE(qbA, qr);
#pragma unroll 1
    for (int u = 0; u < 2; ++u) {
    const int qb = u ? qbB : qbA; const int q0 = qb * 128; const int NT = 2 * (qb + 1);
    f32x16 o[4]; o[0] = f32x16{}; o[1] = f32x16{}; o[2] = f32x16{}; o[3] = f32x16{};
    const f32x16 z16 = f32x16{};
    float l_reg = 0.f; const int qrel = 32 * g + r32;
    f32x16 pA0, pA1, pB0, pB1; bf16x8 kf[8]; u32x4 pw0, pw1, pw2, pw3;
    int sl_prev = 0, sl_cur = 0, sl_next = SLOTB;
#define ROT() do { sl_prev = sl_cur; sl_cur = sl_next; sl_next = (sl_next == (NSLOT - 1) * SLOTB) ? 0 : sl_next + SLOTB; } while (0)
#define KLD(i, base) kf[i] = *(const ALAS bf16x8*)((base) + ((i) >> 1) * 2048 + ((i) & 1) * 512)
    sl_prev = 0; sl_cur = 0; sl_next = SLOTB; l_reg = 0.f; o[0] = f32x16{}; o[1] = f32x16{}; o[2] = f32x16{}; o[3] = f32x16{};
    if (u) { WAIT_BAR(0); } else if (NT > 2) { WAIT_BAR(6); } else { WAIT_BAR(4); }
    {
#pragma unroll
        for (int i = 0; i < 8; ++i) KLD(i, kp0);
        pA0 = MFMA32(kf[0], qr[0], z16); pA1 = MFMA32(kf[1], qr[0], z16);
#pragma unroll
        for (int d0 = 1; d0 < 4; ++d0) { pA0 = MFMA32(kf[2 * d0], qr[d0], pA0); pA1 = MFMA32(kf[2 * d0 + 1], qr[d0], pA1); }
        if (qb == 0) cmask(pA0, pA1, 0, qrel, hi);
#pragma unroll
        for (int r = 0; r < 16; ++r) { pA0[r] = __builtin_amdgcn_exp2f(pA0[r]); pA1[r] = __builtin_amdgcn_exp2f(pA1[r]); }
    }
    WAIT_BAR(0);
    if (NT > 3) DMA_K(3, 0);
    DMA_V(1, SLOTB);
    ROT();
#pragma unroll
    for (int i = 0; i < 8; ++i) KLD(i, kp0 + sl_cur);
    if (NT > 3) { WAIT_BAR(4); } else { WAIT_BAR(0); }
#define PKW(P, B) cvtpk(P[B], P[B + 1])
#define PAF(k) __builtin_bit_cast(bf16x8, pw##k)
#define VRD(j) const s16x4 vl##j = vtr(vp_ + ((((j) & 3) * 4 + ((j) >> 2)) * 1024)), vh##j = vtr(vp_ + ((((j) & 3) * 4 + ((j) >> 2)) * 1024 + 512))
#define VFR(j) (bf16x8){vl##j[0], vl##j[1], vl##j[2], vl##j[3], vh##j[0], vh##j[1], vh##j[2], vh##j[3]}
#define GAPA(MF, A0, A1, A2, A3, W0, W1, PW) do { MF; sacc += A0; sacc += A1; sacc += A2; sacc += A3; PIN(sacc); W0; W1; PIN(PW); SBAR(); } while (0)
#define EX(v) __builtin_amdgcn_exp2f(v)
#define GAPB(j, X, B) do { o[(j) & 3] = MFMA32(PAF_SEL(j), VFR(j), o[(j) & 3]); X[B] = EX(X[B]); X[B + 1] = EX(X[B + 1]); PIN(X); SBAR(); } while (0)
#define PAF_SEL(j) (((j) >> 2) == 0 ? PAF(0) : ((j) >> 2) == 1 ? PAF(1) : ((j) >> 2) == 2 ? PAF(2) : PAF(3))
#define STEP(C0, C1, P0, P1, t, GK, GV, GL, MASKREL) do { SBAR(); \
    const lptr vp_ = vp0 + sl_prev; \
    VRD(0); SBAR(); float sacc = (P0[0] + P0[1]); \
    GAPA(C0 = MFMA32(kf[0], qr[0], z16), P0[2], P0[3], P0[4], P0[5],     pw0[0] = PKW(P0, 0), pw0[1] = PKW(P0, 2), pw0); \
    VRD(1); SBAR(); GAPA(C1 = MFMA32(kf[1], qr[0], z16), P0[6], P0[7], P0[8], P0[9],     pw0[2] = PKW(P0, 4), pw0[3] = PKW(P0, 6), pw0); \
    VRD(2); SBAR(); GAPA(C0 = MFMA32(kf[2], qr[1], C0),  P0[10], P0[11], P0[12], P0[13], pw1[0] = PKW(P0, 8), pw1[1] = PKW(P0, 10), pw1); \
    GAPA(C1 = MFMA32(kf[3], qr[1], C1),  P0[14], P0[15], P1[0], P1[1],   pw1[2] = PKW(P0, 12), pw1[3] = PKW(P0, 14), pw1); \
    GAPA(C0 = MFMA32(kf[4], qr[2], C0),  P1[2], P1[3], P1[4], P1[5],     pw2[0] = PKW(P1, 0), pw2[1] = PKW(P1, 2), pw2); \
    GAPA(C1 = MFMA32(kf[5], qr[2], C1),  P1[6], P1[7], P1[8], P1[9],     pw2[2] = PKW(P1, 4), pw2[3] = PKW(P1, 6), pw2); \
    GAPA(C0 = MFMA32(kf[6], qr[3], C0),  P1[10], P1[11], P1[12], P1[13], pw3[0] = PKW(P1, 8), pw3[1] = PKW(P1, 10), pw3); \
    GAPA(C1 = MFMA32(kf[7], qr[3], C1),  P1[14], P1[15], 0.f, 0.f,       pw3[2] = PKW(P1, 12), pw3[3] = PKW(P1, 14), pw3); \
    l_reg += sacc; \
    if (GK) { DMA_K((t) + 3, sl_cur); } if (GV) { DMA_V((t) + 1, sl_next); } \
    if ((MASKREL) >= 0) cmask(C0, C1, (MASKREL), qrel, hi); \
    SBAR(); \
    const lptr kn_ = kp0 + sl_next; \
    VRD(3);  SBAR(); GAPB(0, C0, 0); \
    VRD(4);  SBAR(); GAPB(1, C0, 2); \
    VRD(5);  SBAR(); GAPB(2, C0, 4); \
    VRD(6);  SBAR(); GAPB(3, C0, 6); \
    VRD(7);  SBAR(); GAPB(4, C0, 8); \
    VRD(8);  SBAR(); GAPB(5, C0, 10); \
    VRD(9);  SBAR(); GAPB(6, C0, 12); \
    VRD(10); SBAR(); GAPB(7, C0, 14); \
    VRD(11); if (GL) { KLD(0, kn_); } SBAR(); GAPB(8, C1, 0); \
    VRD(12); if (GL) { KLD(1, kn_); } SBAR(); GAPB(9, C1, 2); \
    VRD(13); if (GL) { KLD(2, kn_); } SBAR(); GAPB(10, C1, 4); \
    VRD(14); if (GL) { KLD(3, kn_); } SBAR(); GAPB(11, C1, 6); \
    VRD(15); if (GL) { KLD(4, kn_); } SBAR(); GAPB(12, C1, 8); \
    if (GL) { KLD(5, kn_); } SBAR(); GAPB(13, C1, 10); \
    if (GL) { KLD(6, kn_); } SBAR(); GAPB(14, C1, 12); \
    if (GL) { KLD(7, kn_); } SBAR(); GAPB(15, C1, 14); \
    } while (0)
#define ENDW(tt) do { if ((tt) + 3 < NT) { WAIT_BAR(4); } else if ((tt) + 2 < NT) { WAIT_BAR(2); } else { WAIT_BAR(0); } } while (0)
    int t = 1;
    for (; t + 5 < NT; t += 2) {
        STEP(pB0, pB1, pA0, pA1, t, true, true, true, -1);     WAIT_BAR(4); ROT();
        STEP(pA0, pA1, pB0, pB1, t + 1, true, true, true, -1); WAIT_BAR(4); ROT();
    }
    for (; t + 1 < NT; t += 2) {
        STEP(pB0, pB1, pA0, pA1, t, (t + 3 < NT), (t + 1 < NT), (t + 1 < NT), (t - (NT - 2)));             ENDW(t);     ROT();
        STEP(pA0, pA1, pB0, pB1, t + 1, (t + 4 < NT), (t + 2 < NT), (t + 2 < NT), (t + 1 - (NT - 2)));     ENDW(t + 1); ROT();
    }
    STEP(pB0, pB1, pA0, pA1, NT - 1, false, false, false, 1);
    {   float sacc = 0.f;
#pragma unroll
        for (int r = 0; r < 16; ++r) sacc += pB0[r] + pB1[r];
        l_reg += sacc;
        pw0 = (u32x4){PKW(pB0, 0), PKW(pB0, 2), PKW(pB0, 4), PKW(pB0, 6)}; pw1 = (u32x4){PKW(pB0, 8), PKW(pB0, 10), PKW(pB0, 12), PKW(pB0, 14)};
        pw2 = (u32x4){PKW(pB1, 0), PKW(pB1, 2), PKW(pB1, 4), PKW(pB1, 6)}; pw3 = (u32x4){PKW(pB1, 8), PKW(pB1, 10), PKW(pB1, 12), PKW(pB1, 14)};
        const lptr vq = vp0 + sl_cur;
#pragma unroll
        for (int db = 0; db < 4; ++db) {
            { const s16x4 a = vtr(vq + (db * 4 + 0) * 1024), c = vtr(vq + (db * 4 + 0) * 1024 + 512); o[db] = MFMA32(PAF(0), ((bf16x8){a[0], a[1], a[2], a[3], c[0], c[1], c[2], c[3]}), o[db]); }
            { const s16x4 a = vtr(vq + (db * 4 + 1) * 1024), c = vtr(vq + (db * 4 + 1) * 1024 + 512); o[db] = MFMA32(PAF(1), ((bf16x8){a[0], a[1], a[2], a[3], c[0], c[1], c[2], c[3]}), o[db]); }
            { const s16x4 a = vtr(vq + (db * 4 + 2) * 1024), c = vtr(vq + (db * 4 + 2) * 1024 + 512); o[db] = MFMA32(PAF(2), ((bf16x8){a[0], a[1], a[2], a[3], c[0], c[1], c[2], c[3]}), o[db]); }
            { const s16x4 a = vtr(vq + (db * 4 + 3) * 1024), c = vtr(vq + (db * 4 + 3) * 1024 + 512); o[db] = MFMA32(PAF(3), ((bf16x8){a[0], a[1], a[2], a[3], c[0], c[1], c[2], c[3]}), o[db]); }
        }
    }
    LBAR();
    if (u == 0) ISSUE(qbB, qn);
    const int erow = 16 * wid + (lane >> 2), eqd = lane & 3; const size_t grow = rowbase + q0 + erow;
    bf16x8 zz[4]; f32x4 sw0[4], sw1[4];
    { const bf16_t* zp = SZB + grow * 512 + 128 * h + 32 * eqd; const float* sw = subw + 32 * eqd;
#pragma unroll
      for (int i = 0; i < 4; ++i) { zz[i] = *(const bf16x8*)(zp + 8 * i); sw0[i] = *(const f32x4*)(sw + 8 * i); sw1[i] = *(const f32x4*)(sw + 8 * i + 4); } }
    l_reg += __shfl_xor(l_reg, 32);
    ALAS float* wsf = (ALAS float*)(lds + WSF_OFF) + wid * 64;
    if (hi == 0) wsf[r32] = l_reg;
    float rli[16];
#pragma unroll
    for (int r = 0; r < 16; ++r) rli[r] = __builtin_amdgcn_rcpf(wsf[crow(r, hi)]);
    ALAS float* X = (ALAS float*)(lds + XOFF);
    if (sh == 1) {
#pragma unroll
        for (int db = 0; db < 4; ++db)
#pragma unroll
            for (int r = 0; r < 16; ++r) X[(32 * g + crow(r, hi)) * XROW + 32 * db + r32] = lam * o[db][r] * rli[r];
    }
    LBAR();
    if (sh == 0) {
#pragma unroll
        for (int db = 0; db < 4; ++db)
#pragma unroll
            for (int r = 0; r < 16; ++r) { ALAS float* xp = X + (32 * g + crow(r, hi)) * XROW + 32 * db + r32; *xp = o[db][r] * rli[r] - *xp; }
    }
    LBAR();
    {   const ALAS float* xs = X + erow * XROW + 32 * eqd;
        f32x4 v[8]; float ss = 0.f;
#pragma unroll
        for (int i = 0; i < 8; ++i) { v[i] = *(const ALAS f32x4*)(xs + 4 * i); ss += (v[i][0] * v[i][0] + v[i][1] * v[i][1]) + (v[i][2] * v[i][2] + v[i][3] * v[i][3]); }
        ss += __shfl_xor(ss, 1); ss += __shfl_xor(ss, 2);
        const float rstd = __builtin_amdgcn_rsqf(ss * (1.0f / 128.0f) + 1e-5f) * 0.8f;
        bf16_t* op = MIXED + grow * 1024 + 512 + 128 * h + 32 * eqd;
#pragma unroll
        for (int i = 0; i < 4; ++i) { float y[8];
#pragma unroll
            for (int e = 0; e < 4; ++e) { y[e] = v[2 * i][e] * rstd * sw0[i][e] * bf2f((unsigned short)zz[i][e]); y[4 + e] = v[2 * i + 1][e] * rstd * sw1[i][e] * bf2f((unsigned short)zz[i][4 + e]); }
            u32x4 pk; pk.x = cvtpk(y[0], y[1]); pk.y = cvtpk(y[2], y[3]); pk.z = cvtpk(y[4], y[5]); pk.w = cvtpk(y[6], y[7]);
            *(u32x4*)(op + 8 * i) = pk; }
    }
#pragma unroll
    for (int d0 = 0; d0 < 4; ++d0) qr[d0] = qn[d0];
    }
    LBAR();
#undef ISSUE
#undef DMA_K
#undef DMA_V
#undef ROT
#undef KLD
#undef PKW
#undef PAF
#undef VRD
#undef VFR
#undef GAPA
#undef GAPB
#undef EX
#undef STEP
#undef ENDW
#undef PAF_SEL
}
#undef SBAR
#undef PIN
#undef MFMA32
#undef WAIT_BAR
}
constexpr int NWAVES = 8;
constexpr int RING_OFF = 0, RING_BYTES = 131072;
constexpr int LDS_BYTES = 147456;
constexpr int MISC_OFF = LDS_BYTES - 512;
static_assert(att::ATT_LDS_END <= MISC_OFF && att2::ATT2_LDS_END <= MISC_OFF, "attention LDS map");
constexpr int CW_BAR = 4096;
constexpr int NPHASE = 5;
#ifndef G1_ALIGN
#define G1_ALIGN true
#endif
#ifndef G1_SP2
#define G1_SP2 true
#endif
#ifndef G2_ALIGN
#define G2_ALIGN true
#endif
#ifndef G2_SP2
#define G2_SP2 true
#endif

__device__ __forceinline__ float wave_sum(float v) {
#pragma unroll
    for (int o = 1; o < 64; o <<= 1) v += __shfl_xor(v, o);
    return v;
}
__device__ __forceinline__ int virt_row(int n0) {
    if (n0 < 512) { const int hA = n0 >> 7; return 256 * (hA < 2 ? hA : 6 + hA) + (n0 & 127); }
    if (n0 < 1024) return 1024 + (n0 - 512);
    if (n0 < 1536) { const int c = n0 - 1024, hA = c >> 7; return 256 * (hA < 2 ? hA : 6 + hA) + 128 + (c & 127); }
    if (n0 < 2560) { const int isk = n0 >= 2048, c = n0 - (isk ? 2048 : 1536), head = c >> 6, bj = (c >> 5) & 1;
        return 256 * ((isk ? 6 : 2) + (head >> 2)) + 128 * bj + 32 * (head & 3); }
    return n0;
}
__device__ __forceinline__ void p0_transpose_item(const float* W, int K, int N, bf16* WT, bool virt, LAS float* scr, int item, int lane) {
    const int nblk = N / 32, kb = item / nblk, nb = item % nblk, k0 = 64 * kb, n0 = 32 * nb;
#pragma unroll
    for (int i = 0; i < 32; ++i) { const int kk = 2 * i + (lane >> 5); scr[kk * 33 + (lane & 31)] = W[(size_t)(k0 + kk) * N + n0 + (lane & 31)]; }
    LDS_WAIT(); asm volatile("" ::: "memory");
    const int c = lane & 7; const int vr0 = virt ? virt_row(n0) : n0;
#pragma unroll
    for (int j = 0; j < 4; ++j) { const int n = (lane >> 3) + 8 * j; const LAS float* s = scr + (8 * c) * 33 + n;
        v4u o; o.x = pk2(s[0 * 33], s[1 * 33]); o.y = pk2(s[2 * 33], s[3 * 33]); o.z = pk2(s[4 * 33], s[5 * 33]); o.w = pk2(s[6 * 33], s[7 * 33]);
        *(GAS v4u*)(WT + (size_t)(vr0 + n) * K + k0 + 8 * c) = o; }
    LDS_WAIT(); asm volatile("" ::: "memory");
}

struct Args { const void* in[18]; float* out; unsigned char* ws; int ph_lo, ph_hi, li, pad; };
__global__ void __launch_bounds__(NWAVES * 64, 2) mk_fwd(Args args) {
    extern __shared__ __attribute__((aligned(16))) unsigned char lds_raw[];
    LAS unsigned char* lds = (LAS unsigned char*)lds_raw;
    const int tid = threadIdx.x, lane = tid & 63, wave = __builtin_amdgcn_readfirstlane(tid >> 6);
    const int G = gridDim.x, bx = blockIdx.x; const int vcu = (G % 8 == 0) ? (bx % 8) * (G / 8) + bx / 8 : bx;
    volatile LAS unsigned* MISC = (volatile LAS unsigned*)(lds + MISC_OFF);
    for (int u = tid; u < (LDS_BYTES - MISC_OFF) / 4; u += NWAVES * 64) MISC[u] = 0u;
    __syncthreads();
    unsigned char* ws = args.ws;
    gu32* ctl = (gu32*)(ws + WS_CTL);
    const float* x = (const float*)args.in[0]; const float* cc = (const float*)args.in[1]; const int* pos = (const int*)args.in[2];
    const float* norm_w = (const float*)args.in[3]; const float* w_ada = (const float*)args.in[4]; const float* b_ada = (const float*)args.in[5];
    const float* w_in = (const float*)args.in[6]; const float* sgw = (const float*)args.in[7]; const float* w_s = (const float*)args.in[8]; const float* b_s = (const float*)args.in[9];
    const float* qnw = (const float*)args.in[10]; const float* knw = (const float*)args.in[11];
    const float* subw = (const float*)args.in[16]; const float* w_out = (const float*)args.in[17];
    bf16* WIN = (bf16*)(ws + WS_WIN); bf16* WOUT = (bf16*)(ws + WS_WOUT); bf16* WSB = (bf16*)(ws + WS_WSB);
    float* MOD = (float*)(ws + WS_MOD); float* LAMP = (float*)(ws + WS_LAM); float* MODP = (float*)(ws + WS_MODP); float* SSQ = (float*)(ws + WS_SSQ);
    bf16* H = (bf16*)(ws + WS_H); bf16* MIXED = (bf16*)(ws + WS_MIXED); bf16* GB = (bf16*)(ws + WS_G); bf16* VA = (bf16*)(ws + WS_VA);
    bf16* QB = (bf16*)(ws + WS_Q); bf16* KB = (bf16*)(ws + WS_K); bf16* VB = (bf16*)(ws + WS_VB); bf16* SZB = (bf16*)(ws + WS_SZB);
    const int lo = args.ph_lo, hi = args.ph_hi;
    XcdBarrier bar; bar.bar = (unsigned*)(ctl + CW_BAR) + args.li * XCD_BAR_WORDS; bar.x = 0; bar.st = nullptr;
    if (hi - lo > 1) bar = xcd_barrier_post((unsigned*)(ctl + CW_BAR) + args.li * XCD_BAR_WORDS, MISC + 8);
#define IN(k) (lo <= (k) && (k) < hi)
#ifdef MK_TPROBE
#define STAMP(k) do { if (tid == 0) { const unsigned long long t_ = __builtin_amdgcn_s_memrealtime(); MISC[32 + 2 * (k)] = (unsigned)t_; MISC[33 + 2 * (k)] = (unsigned)(t_ >> 32); } } while (0)
#else
#define STAMP(k) do { } while (0)
#endif
    STAMP(0);
#ifndef MK_REP
#define MK_REP (-1)
#endif
#define REPS(k) ((MK_REP == (k)) ? 2 : 1)
#define ENDPH(k) do { if (BOTH(k) || rep + 1 < REPS(k)) xcd_barrier<false>(bar); } while (0)
#define BOTH(k) (IN(k) && IN((k) + 1))

    f32x4 xv[8][4]; bool xpre = false;
    if (IN(0)) _Pragma("unroll 1") for (int rep = 0; rep < REPS(0); ++rep) {
        LAS float* scr = (LAS float*)(lds + RING_OFF + wave * 16384);
        const int gw = vcu * NWAVES + wave, NGW = G * NWAVES;
        constexpr int I_MOD = 16 * 48, I_WIN = 16 * (NIN / 32), I_WOUT = 16 * 32, I_WS = 64;
        for (int r = gw; r < I_MOD; r += NGW) {
            {   const int ks = r / 48, k0 = 64 * ks, j0 = 64 * (r % 48);
#pragma unroll
                for (int b = 0; b < 8; ++b) { const float v = cc[b * 1024 + k0 + lane]; scr[b * 64 + lane] = v * __builtin_amdgcn_rcpf(1.f + __expf(-v)); }
                LDS_WAIT(); asm volatile("" ::: "memory");
                float acc[8];
#pragma unroll
                for (int b = 0; b < 8; ++b) acc[b] = 0.f;
#pragma unroll 1
                for (int kh = 0; kh < 2; ++kh) {
                    float wv[32];
#pragma unroll
                    for (int k = 0; k < 32; ++k) wv[k] = w_ada[(size_t)(k0 + 32 * kh + k) * 3072 + j0 + lane];
#pragma unroll
                    for (int kc = 0; kc < 4; ++kc) {
#pragma unroll
                        for (int b = 0; b < 8; ++b) { const f32x4 c0 = *(const LAS f32x4*)(scr + b * 64 + 32 * kh + 8 * kc), c1 = *(const LAS f32x4*)(scr + b * 64 + 32 * kh + 8 * kc + 4);
                            acc[b] += (c0.x * wv[8 * kc] + c0.y * wv[8 * kc + 1]) + (c0.z * wv[8 * kc + 2] + c0.w * wv[8 * kc + 3]) + (c1.x * wv[8 * kc + 4] + c1.y * wv[8 * kc + 5]) + (c1.z * wv[8 * kc + 6] + c1.w * wv[8 * kc + 7]); }
                        asm volatile("" ::: "memory"); } }
                const float bias = (ks == 0) ? b_ada[j0 + lane] : 0.f;
#pragma unroll
                for (int b = 0; b < 8; ++b) MODP[(size_t)(ks * 8 + b) * 3072 + j0 + lane] = acc[b] + bias;
                LDS_WAIT(); asm volatile("" ::: "memory"); }
        }
        asm volatile("" ::: "memory");
        const bool spl = NGW > I_MOD + 512; const int gw2 = spl ? gw - I_MOD : (gw + NGW - (I_MOD % NGW)) % NGW, st2 = spl ? NGW - I_MOD : NGW;
        for (int it = (gw2 < 0 ? I_WIN + I_WOUT + I_WS : gw2); it < I_WIN + I_WOUT + I_WS; it += st2) {
            int r = it;
            if (r < I_WIN) { p0_transpose_item(w_in, 1024, NIN, WIN, true, scr, r, lane); continue; } r -= I_WIN;
            if (r < I_WOUT) { p0_transpose_item(w_out, 1024, 1024, WOUT, false, scr, r, lane); continue; } r -= I_WOUT;
            {   const int idx = r * 1024 + lane * 16, t = (idx >> 7) & 127, s0 = idx & 127; const float* src = w_s + idx;
                v4u o0, o1; float v[16];
#pragma unroll
                for (int e = 0; e < 16; ++e) v[e] = (s0 + e <= t) ? src[e] : 0.f;
                o0.x = pk2(v[0], v[1]); o0.y = pk2(v[2], v[3]); o0.z = pk2(v[4], v[5]); o0.w = pk2(v[6], v[7]);
                o1.x = pk2(v[8], v[9]); o1.y = pk2(v[10], v[11]); o1.z = pk2(v[12], v[13]); o1.w = pk2(v[14], v[15]);
                *(GAS v4u*)(WSB + idx) = o0; *(GAS v4u*)(WSB + idx + 8) = o1; }
        }
        if (bx == 0 && wave == 0) {
            const float* lq1 = (const float*)args.in[12]; const float* lk1 = (const float*)args.in[13]; const float* lq2 = (const float*)args.in[14]; const float* lk2 = (const float*)args.in[15];
            const float a = wave_sum(lq1[lane] * lk1[lane]), b2 = wave_sum(lq2[lane] * lk2[lane]);
            if (lane == 0) LAMP[0] = __expf(a) - __expf(b2) + 0.2f;
        }
        if (BOTH(0) && REPS(0) == 1 && vcu < 256) {
            asm volatile("s_waitcnt vmcnt(0)" ::: "memory");
            if (wave != 0) {
#pragma unroll
                for (int i = 0; i < 8; ++i) { const GAS f32x4* xr = (const GAS f32x4*)(x + ((size_t)vcu * 64 + wave * 8 + i) * 1024) + lane;
#pragma unroll
                    for (int j = 0; j < 4; ++j) xv[i][j] = xr[64 * j]; }
            }
            xpre = true;
            xcd_barrier<true>(bar);
        } else ENDPH(0);
        STAMP(1);
    }
    if (IN(1)) _Pragma("unroll 1") for (int rep = 0; rep < REPS(1); ++rep) {
        LAS float* g1s = (LAS float*)(lds + RING_OFF); LAS float* shs = g1s + 1024;
        for (int blk = vcu; blk < 256; blk += G) {
            const int b = blk >> 5;
            if (!(xpre && blk == vcu && wave != 0)) {
#pragma unroll
                for (int i = 0; i < 8; ++i) { const GAS f32x4* xr = (const GAS f32x4*)(x + ((size_t)blk * 64 + wave * 8 + i) * 1024) + lane;
#pragma unroll
                    for (int j = 0; j < 4; ++j) xv[i][j] = xr[64 * j]; }
            }
            for (int k = tid; k < 1024; k += NWAVES * 64) { float sc = 0.f, sf = 0.f;
#pragma unroll
                for (int ks = 0; ks < 16; ++ks) { sf += MODP[(size_t)(ks * 8 + b) * 3072 + k]; sc += MODP[(size_t)(ks * 8 + b) * 3072 + 1024 + k]; }
                g1s[k] = norm_w[k] * (1.f + sc); shs[k] = sf; }
            if (tid < 96) { const int j = 96 * (blk & 31) + tid; float s = 0.f;
#pragma unroll
                for (int ks = 0; ks < 16; ++ks) s += MODP[(size_t)(ks * 8 + b) * 3072 + j];
                MOD[b * 3072 + j] = s; }
            __syncthreads();
            f32x4 gg[4], ss[4];
#pragma unroll
            for (int j = 0; j < 4; ++j) { gg[j] = *(const LAS f32x4*)(g1s + 4 * lane + 256 * j); ss[j] = *(const LAS f32x4*)(shs + 4 * lane + 256 * j); }
#pragma unroll
            for (int i = 0; i < 8; ++i) { const size_t row = (size_t)blk * 64 + wave * 8 + i; float s = 0.f;
#pragma unroll
                for (int j = 0; j < 4; ++j) s += (xv[i][j].x * xv[i][j].x + xv[i][j].y * xv[i][j].y) + (xv[i][j].z * xv[i][j].z + xv[i][j].w * xv[i][j].w);
                const float rstd = __builtin_amdgcn_rsqf(wave_sum(s) * (1.f / 1024.f) + 1e-6f);
                GAS unsigned long long* o8 = (GAS unsigned long long*)(H + row * 1024) + lane;
#pragma unroll
                for (int j = 0; j < 4; ++j) { const f32x4 hv = xv[i][j] * rstd * gg[j] + ss[j];
                    o8[64 * j] = (unsigned long long)pk2(hv.x, hv.y) | ((unsigned long long)pk2(hv.z, hv.w) << 32); }
            }
            __syncthreads();
        }
        ENDPH(1);
        STAMP(2);
    }
    if (IN(2)) _Pragma("unroll 1") for (int rep = 0; rep < REPS(2); ++rep) {
        pg8::Gemm g{H, WIN, MROWS, NIN, 1024}; pg8::StaticOrder S; S.init(MROWS, NIN, G, bx);
        pg8::Epi1 E{GB, VA, QB, KB, VB, SZB, SSQ, pos, qnw, knw};
        pg8::gemm_phase<pg8::Epi1, pg8::StaticOrder, G1_ALIGN, G1_SP2>(lds + RING_OFF, g, S, E);
        ENDPH(2);
        STAMP(3);
    }
    if (IN(3)) _Pragma("unroll 1") for (int rep = 0; rep < REPS(3); ++rep) {
        const float lam = LAMP[0]; const unsigned lds0 = (unsigned)(uintptr_t)lds_raw;
        for (int v = vcu; v < 256; v += G) {
            const int bh = v >> 3, s = v & 7;
#ifndef MK_REP_ATTN
#define MK_REP_ATTN 1
#endif
#ifndef MK_REP_GMLP
#define MK_REP_GMLP 1
#endif
#pragma unroll 1
            for (int i = 0; i < MK_REP_ATTN; ++i) { att2::attn_pair(lds, lds0, bh >> 2, bh & 3, 15 - s, s, QB, KB, VB, SZB, MIXED, subw, lam); STAMP(9); }
#pragma unroll 1
            for (int ii = 0; ii < MK_REP_GMLP; ++ii) att::gmlp_pair(lds, 2 * v, 2 * v + 1, WSB, VA, SSQ, sgw, b_s, GB, MIXED);
            STAMP(10);
        }
        ENDPH(3);
        STAMP(4);
    }
    if (IN(4)) _Pragma("unroll 1") for (int rep = 0; rep < REPS(4); ++rep) {
        pg8::Gemm g{MIXED, WOUT, MROWS, 1024, 1024}; pg8::StaticOrder S; S.init(MROWS, 1024, G, bx);
        pg8::Epi2 E{x, MOD, args.out};
#if defined(MK_PROBE4) && MK_PROBE4 == 1
        { pg8::EpiNull EN; pg8::gemm_phase<pg8::EpiNull, pg8::StaticOrder, false, true>(lds + RING_OFF, g, S, EN); }
        pg8::gemm_phase<pg8::Epi2, pg8::StaticOrder, false, true>(lds + RING_OFF, g, S, E);
#elif defined(MK_PROBE4) && MK_PROBE4 == 2
        { pg8::Epi2x2 E2{E}; pg8::gemm_phase<pg8::Epi2x2, pg8::StaticOrder, false, true>(lds + RING_OFF, g, S, E2); }
#else
        pg8::gemm_phase<pg8::Epi2, pg8::StaticOrder, G2_ALIGN, G2_SP2>(lds + RING_OFF, g, S, E);
#endif
        ENDPH(4);
        STAMP(5);
#ifdef MK_TPROBE
        if (bx == MK_TBLK && tid == 0) {
            const unsigned long long ta = ((unsigned long long)MISC[33 + 2 * (MK_TA)] << 32) | MISC[32 + 2 * (MK_TA)], tb = ((unsigned long long)MISC[33 + 2 * (MK_TB)] << 32) | MISC[32 + 2 * (MK_TB)];
            const unsigned long long dt = (tb - ta) * MK_TMULT, t0_ = __builtin_amdgcn_s_memrealtime();
            while (__builtin_amdgcn_s_memrealtime() - t0_ < dt) __builtin_amdgcn_s_sleep(8);
        }
#endif
    }
#undef IN
#undef BOTH
}
#ifndef MK_N_LAUNCHES
#define MK_N_LAUNCHES 1
#endif
extern "C" void kernel_launch(void* const* d_in, const int* in_sizes, int n_in, void* d_out, int out_size, void* d_ws, size_t ws_size, hipStream_t stream) {
    static int grid = 0;
    if (grid == 0) {
        if (n_in != 18 || out_size != MROWS * DMODEL || ws_size < WS_END) { fprintf(stderr, "kernel_launch: unexpected sizes (n_in %d out %d ws %zu)\n", n_in, out_size, ws_size); grid = -1; return; }
        int dev = 0, cus = 0, per_cu = 0;
        if (hipGetDevice(&dev) != hipSuccess || hipDeviceGetAttribute(&cus, hipDeviceAttributeMultiprocessorCount, dev) != hipSuccess) { grid = -1; return; }
        if (hipFuncSetAttribute((const void*)mk_fwd, hipFuncAttributeMaxDynamicSharedMemorySize, LDS_BYTES) != hipSuccess) { fprintf(stderr, "kernel_launch: hipFuncSetAttribute failed\n"); grid = -1; return; }
        if (hipOccupancyMaxActiveBlocksPerMultiprocessor(&per_cu, (const void*)mk_fwd, NWAVES * 64, LDS_BYTES) != hipSuccess || per_cu < 1) { fprintf(stderr, "kernel_launch: occupancy query says %d blocks per CU\n", per_cu); }
        (void)hipGetLastError();
        grid = cus;
    }
    if (grid < 0) return;
    (void)hipMemsetAsync((char*)d_ws + WS_CTL, 0, CTL_ZERO_BYTES, stream);
    Args a{};
    for (int i = 0; i < 18; ++i) a.in[i] = d_in[i];
    a.out = (float*)d_out; a.ws = (unsigned char*)d_ws;
#if MK_N_LAUNCHES == 1
    a.ph_lo = 0; a.ph_hi = NPHASE; a.li = 0;
    hipLaunchKernelGGL(mk_fwd, dim3(grid), dim3(NWAVES * 64), LDS_BYTES, stream, a);
#else
#ifndef MK_REPL
#define MK_REPL (-1)
#endif
    for (int p = 0; p < NPHASE; ++p) { a.ph_lo = p; a.ph_hi = p + 1; a.li = p; hipLaunchKernelGGL(mk_fwd, dim3(grid), dim3(NWAVES * 64), LDS_BYTES, stream, a);
        if (p == MK_REPL) hipLaunchKernelGGL(mk_fwd, dim3(grid), dim3(NWAVES * 64), LDS_BYTES, stream, a); }
#endif
}
```

```cpp
#include <hip/hip_runtime.h>
#include <cstdio>
#include <cstdint>
constexpr int BATCH = 8, SEQ = 2048, DMODEL = 1024, MROWS = BATCH * SEQ, NIN = 3584;
constexpr float C2Q = 0.125f * 1.4426950408889634f;
constexpr size_t MiB = 1u << 20;
constexpr size_t WS_CTL = 0, CTL_ZERO_BYTES = 1 * MiB;
constexpr size_t WS_WIN = 1 * MiB;
constexpr size_t WS_WOUT = 8 * MiB;
constexpr size_t WS_WSB = 10 * MiB;
constexpr size_t WS_MOD = 10 * MiB + 256 * 1024;
constexpr size_t WS_LAM = 10 * MiB + 384 * 1024;
constexpr size_t WS_MODP = 10 * MiB + 512 * 1024;
constexpr size_t WS_SSQ = 12 * MiB;
constexpr size_t WS_H = 13 * MiB;
constexpr size_t WS_MIXED = 142 * MiB;
constexpr size_t WS_G = 45 * MiB;
constexpr size_t WS_VA = 61 * MiB;
constexpr size_t WS_Q = 77 * MiB;
constexpr size_t WS_K = 93 * MiB;
constexpr size_t WS_VB = 109 * MiB;
constexpr size_t WS_SZB = 125 * MiB;
constexpr size_t WS_T0 = 141 * MiB;
constexpr size_t WS_T1 = 173 * MiB;
constexpr size_t WS_END = 174 * MiB;
#define GAS __attribute__((address_space(1)))
#define LAS __attribute__((address_space(3)))
typedef unsigned short bf16;
typedef unsigned v4u __attribute__((ext_vector_type(4)));
typedef float f32x4 __attribute__((ext_vector_type(4)));
typedef short bf16x8 __attribute__((ext_vector_type(8)));
typedef GAS unsigned gu32;
typedef GAS unsigned long long gu64;
#define RLX_AGENT __ATOMIC_RELAXED, __HIP_MEMORY_SCOPE_AGENT
#define LDS_WAIT() asm volatile("s_waitcnt lgkmcnt(0)" ::: "memory")
#define VM_WAIT() asm volatile("s_waitcnt vmcnt(0)" ::: "memory")
__device__ __forceinline__ unsigned long long rt() { return __builtin_amdgcn_s_memrealtime(); }
__device__ __forceinline__ unsigned f2bf(float f) { unsigned u = __builtin_bit_cast(unsigned, f); return (u + 0x7fffu + ((u >> 16) & 1u)) >> 16; }
__device__ __forceinline__ unsigned pk2(float lo, float hi) { return f2bf(lo) | (f2bf(hi) << 16); }
#define XB_TMO      128
#define XB_XCNT(j)  (256  + 64 * (j))
#define XB_XSUB(j)  (1280 + 64 * (j))
#define XB_XGEN(j)  (2304 + 64 * (j))
#define XB_TOP      3328
#define XB_TOPGEN   3392
#define XCD_BAR_WORDS 3456
#define XB_SPIN_CAP (1u << 18)

__device__ __forceinline__ unsigned xb_ld(unsigned* p)              { return __hip_atomic_load(p, __ATOMIC_RELAXED, __HIP_MEMORY_SCOPE_AGENT); }
__device__ __forceinline__ unsigned xb_add(unsigned* p, unsigned v) { return __hip_atomic_fetch_add(p, v, __ATOMIC_RELAXED, __HIP_MEMORY_SCOPE_AGENT); }
__device__ __forceinline__ unsigned xb_xcc_id() { return (unsigned)__builtin_amdgcn_s_getreg((3 << 11) | 20) & 0xFu; }
#define XB_SPIN(cond, bar) do { unsigned _sp = 0; while (cond) { __builtin_amdgcn_s_sleep(1); \
    if ((++_sp & 255u) == 0u) { if (xb_ld(&(bar)[XB_TMO])) break; if (_sp > XB_SPIN_CAP) { atomicAdd(&(bar)[XB_TMO], 1u); break; } } } } while (0)

template <bool EQ>
__device__ __forceinline__ void xb_poll(unsigned* p, unsigned v, unsigned* bar) {
    unsigned a = xb_ld(p);
    __builtin_amdgcn_s_sleep(14);
    unsigned sp = 0;
    for (;;) { const unsigned b = xb_ld(p);
        if (EQ ? (a != v) : (a >= v)) return;
        a = b;
        if ((++sp & 255u) == 0u) { if (xb_ld(&bar[XB_TMO])) return; if (sp > XB_SPIN_CAP) { atomicAdd(&bar[XB_TMO], 1u); return; } } }
}

struct XcdBarrier {
    unsigned* bar; unsigned x;
    volatile LAS unsigned* st;
    unsigned tot;
};

__device__ __forceinline__ XcdBarrier xcd_barrier_post(unsigned* bar, volatile LAS unsigned* st, unsigned tot) {
    XcdBarrier b; b.bar = bar; b.x = xb_xcc_id(); b.st = st; b.tot = tot;
    if (threadIdx.x == 0) (void)xb_add(&bar[XB_XCNT(b.x)], 1u);
    return b;
}
__device__ __forceinline__ void xcd_barrier_complete(unsigned* bar, unsigned x, unsigned G, unsigned& nloc, unsigned& nx) {
    unsigned sum, cnt, mine, sp = 0u;
    for (;;) {
        sum = 0u; cnt = 0u; mine = 0u;
#pragma unroll
        for (unsigned j = 0; j < 16; ++j) { const unsigned c = xb_ld(&bar[XB_XCNT(j)]); sum += c; cnt += (c > 0u) ? 1u : 0u; mine = (j == x) ? c : mine; }
        if (sum == G) break;
        __builtin_amdgcn_s_sleep(1);
        if ((++sp & 255u) == 0u) { if (xb_ld(&bar[XB_TMO])) break; if (sp > XB_SPIN_CAP) { atomicAdd(&bar[XB_TMO], 1u); break; } }
    }
    nloc = mine > 0u ? mine : 1u; nx = cnt > 0u ? cnt : 1u;
}

template <bool DRAINED = false, bool GCEN = false>
__device__ __forceinline__ void xcd_barrier(const XcdBarrier& b, const XcdBarrier* gb = nullptr) {
    if (!DRAINED) asm volatile("s_waitcnt vmcnt(0)" ::: "memory");
    __syncthreads();
    if (threadIdx.x == 0) {
        unsigned* bar = b.bar;
        __builtin_amdgcn_s_waitcnt(0);
        unsigned nloc = b.st[0], nx = b.st[1];
        if (nloc == 0u) { xcd_barrier_complete(bar, b.x, b.tot, nloc, nx); b.st[0] = nloc; b.st[1] = nx; }
        unsigned gc[16]; bool needg = false;
        if constexpr (GCEN) { needg = gb->st[0] == 0u;
            if (needg) {
#pragma unroll
                for (int j = 0; j < 16; ++j) gc[j] = xb_ld(&gb->bar[XB_XCNT(j)]); } }
        const unsigned old = xb_add(&bar[XB_XSUB(b.x)], 1u);
        if constexpr (GCEN) { if (needg) { unsigned sum = 0u, cnt = 0u, mine = 0u;
#pragma unroll
                for (unsigned j = 0; j < 16; ++j) { const unsigned c = gc[j]; sum += c; cnt += (c > 0u) ? 1u : 0u; mine = (j == gb->x) ? c : mine; }
                if (sum != gb->tot) xcd_barrier_complete(gb->bar, gb->x, gb->tot, mine, cnt);
                gb->st[0] = mine > 0u ? mine : 1u; gb->st[1] = cnt > 0u ? cnt : 1u; } }
        const unsigned gen = old / nloc;
        if (old + 1u == (gen + 1u) * nloc) {
            if (nx > 1u) {
            __builtin_amdgcn_fence(__ATOMIC_RELEASE, "agent");
            asm volatile("s_waitcnt vmcnt(0)" ::: "memory");
            const unsigned og = xb_add(&bar[XB_TOP], 1u);
            const unsigned tg = og / nx;
            if (og + 1u == (tg + 1u) * nx) xb_add(&bar[XB_TOPGEN], 1u);
            else xb_poll<true>(&bar[XB_TOPGEN], tg, bar);
            }
            __builtin_amdgcn_fence(__ATOMIC_ACQUIRE, "agent");
            xb_add(&bar[XB_XGEN(b.x)], 1u);
            asm volatile("s_waitcnt vmcnt(0)" ::: "memory");
        } else {
            xb_poll<true>(&bar[XB_XGEN(b.x)], gen, bar);
            __builtin_amdgcn_fence(__ATOMIC_ACQUIRE, "agent");
            asm volatile("s_waitcnt vmcnt(0)" ::: "memory");
        }
    }
    __syncthreads();
}
namespace pg8 {
#define PG8_LAS __attribute__((address_space(3)))
typedef unsigned short bf16_t;
typedef short bf16x8 __attribute__((ext_vector_type(8)));
typedef float f32x4 __attribute__((ext_vector_type(4)));
typedef unsigned u32x4 __attribute__((ext_vector_type(4)));
constexpr int BM = 256, BK = 64, HALF = 128, HTB = HALF * BK * 2  , STAGE_BYTES = 8 * HTB, NXCD = 8, WGM = 8;

__host__ __device__ __forceinline__ int lds_byte(int r, int c) { const int st = (r >> 4) * 2 + (c >> 5), rr = r & 15, cc = c & 31, ob = rr * 64 + cc * 2; return st * 1024 + (ob ^ (((ob >> 9) & 1) << 5)); }
__host__ __device__ __forceinline__ void stage_rc(int b, int& R, int& C) { const int st = b / 1024, sb = b % 1024, swz = sb ^ (((sb >> 9) & 1) << 5); R = (st >> 1) * 16 + swz / 64; C = (st & 1) * 32 + (swz % 64) / 2; }
__host__ __device__ __forceinline__ int perm32(int rho) { const int n = rho >> 4, i = rho & 15; return 8 * (i >> 2) + 4 * n + (i & 3); }

struct Unit { int pm, pn, half; };
struct Gemm { const bf16_t* A; const bf16_t* Bt; int M, N, K; };

struct StaticOrder {
    static constexpr bool HAS_MID = false;
    int nM, nN, nwg, G, c;
    __host__ __device__ void init(int M, int N, int G_, int c_) { nM = M / BM; nN = N / BM; nwg = nM * nN; G = G_; c = c_; }
    __host__ __device__ bool next(int i, Unit& u) const {
        const long L = (long)i * G + c; if (L >= nwg) return false;
        int wgid = (int)L; { const int q = nwg / NXCD, r = nwg % NXCD, xcd = wgid % NXCD, off = wgid / NXCD; wgid = (xcd < r ? xcd * (q + 1) : r * (q + 1) + (xcd - r) * q) + off; }
        const int nig = WGM * nN, gid = wgid / nig, fm = gid * WGM, gsz = (nM - fm) < WGM ? (nM - fm) : WGM;
        u.pm = fm + ((wgid % nig) % gsz); u.pn = (wgid % nig) / gsz; u.half = -1; return true;
    }
    __device__ __forceinline__ void a_ready(const Unit&) const {}
    __device__ __forceinline__ void done(const Unit&) const {}
};

struct Order1s : StaticOrder {
    static constexpr bool HAS_MID = true;
    unsigned* cnt; bool on;
    __device__ __forceinline__ void mid(int ui, int tid) const { if (on && tid == 0 && (ui == 2 || ui == 3)) (void)xb_add(cnt + 64 * (ui - 2), 1u); }
};

struct Order1 {
    StaticOrder so; bool split;
    __host__ __device__ void init(int M, int N, int G_, int c_) { so.init(M, N, G_, c_); split = (G_ == 256 && M == 16384 && N == 3584); }
    __host__ __device__ bool next(int i, Unit& u) const {
        if (!split || i < 3) return so.next(i, u);
        if (i > 3) return false;
        const int x = so.c & 7, j = so.c >> 3, q = j >> 3; u.pm = 8 * x + (j & 7); u.pn = 12 + (q >> 1); u.half = q & 1; return true;
    }
    __device__ __forceinline__ void a_ready(const Unit&) const {}
    __device__ __forceinline__ void done(const Unit&) const {}
};

__device__ __forceinline__ unsigned cvt_pk_bf16(float lo, float hi) { unsigned r; asm volatile("v_cvt_pk_bf16_f32 %0, %1, %2" : "=v"(r) : "v"(lo), "v"(hi)); return r; }
typedef float f32x2 __attribute__((ext_vector_type(2)));
__device__ __forceinline__ float silu_f(float z) { return z * __builtin_amdgcn_rcpf(1.f + __builtin_amdgcn_exp2f(-1.4426950408889634f * z)); }
typedef float f32x2 __attribute__((ext_vector_type(2)));
#define PG8_LO2(v) __builtin_shufflevector(v, v, 0, 1)
#define PG8_HI2(v) __builtin_shufflevector(v, v, 2, 3)
#define PG8_CAT4(lo, hi) __builtin_shufflevector(lo, hi, 0, 1, 2, 3)
__device__ __forceinline__ f32x2 silu2(f32x2 z) { const f32x2 t = z * -1.4426950408889634f; f32x2 d; d.x = __builtin_amdgcn_exp2f(t.x); d.y = __builtin_amdgcn_exp2f(t.y); d = d + 1.0f;
    f32x2 r; r.x = __builtin_amdgcn_rcpf(d.x); r.y = __builtin_amdgcn_rcpf(d.y); return z * r; }
__device__ __forceinline__ f32x4 silu4(const f32x4& z) { return PG8_CAT4(silu2(PG8_LO2(z)), silu2(PG8_HI2(z))); }
__device__ __forceinline__ void glds16s2nt(unsigned voff0, unsigned voff1, const void* sbase, unsigned lds_dst) { unsigned keep;
    asm volatile("s_mov_b32 %0, m0\n\ts_mov_b32 m0, %4\n\ts_nop 0\n\tglobal_load_lds_dwordx4 %1, %3 nt\n\ts_add_u32 m0, %4, 0x2000\n\ts_nop 0\n\tglobal_load_lds_dwordx4 %2, %3 nt\n\ts_mov_b32 m0, %0"
                 : "=&s"(keep) : "v"(voff0), "v"(voff1), "s"(sbase), "s"(lds_dst) : "memory", "scc"); }
__device__ __forceinline__ void store8(bf16_t* p, const f32x4& a, const f32x4& b) {
    u32x4 w; w.x = cvt_pk_bf16(a[0], a[1]); w.y = cvt_pk_bf16(a[2], a[3]); w.z = cvt_pk_bf16(b[0], b[1]); w.w = cvt_pk_bf16(b[2], b[3]); *(u32x4*)p = w; }
struct Epi1 {
    static constexpr bool PERM = true, AFTER_DRAIN = false, XPRE = false;
    bf16_t *G, *VA, *Q, *K, *VB, *SZB; float* SSQ; const int* pos; const float *qnw, *knw;
    __device__ __forceinline__ void operator()(const f32x4 (&acc)[2][2][4][2], const Unit& u, int wr, int wc, int fr, int fq) const {
        asm volatile("" : "+v"(fr), "+v"(fq));
        const int row0 = u.pm * BM + wr * 64 + fr; const int p2 = u.pn >> 1, lo1 = u.pn & 1;
        const int pn = (p2 == 0) ? lo1 : (p2 == 1) ? 6 + lo1 : (p2 == 2) ? 4 + lo1 : (p2 == 3) ? 8 + lo1 : (p2 == 4) ? 2 + lo1 : (p2 == 5) ? 10 + lo1 : 12 + lo1;
        if (pn < 4) {
            bf16_t* base = G + (size_t)row0 * 512 + pn * 128 + wc * 32 + 8 * fq;
#pragma unroll
            for (int ai = 0; ai < 2; ++ai)
#pragma unroll
                for (int m = 0; m < 4; ++m) { f32x4 g0, g1;
#pragma unroll
                    for (int e = 0; e < 1; ++e) { g0 = acc[ai][0][m][0] * silu4(acc[ai][1][m][0]); g1 = acc[ai][0][m][1] * silu4(acc[ai][1][m][1]); }
                    store8(base + (size_t)(ai * HALF + m * 16) * 512, g0, g1); }
        } else if (pn < 6) {
#pragma unroll
            for (int ai = 0; ai < 2; ++ai)
#pragma unroll
                for (int m = 0; m < 4; ++m) { const int row = row0 + ai * HALF + m * 16;
#pragma unroll
                    for (int bj = 0; bj < 2; ++bj) { const f32x4 a = acc[ai][bj][m][0], b = acc[ai][bj][m][1];
                        store8(VA + (size_t)row * 512 + (pn - 4) * 256 + bj * 128 + wc * 32 + 8 * fq, a, b);
                        const f32x2 q2 = (PG8_LO2(a) * PG8_LO2(a) + PG8_HI2(a) * PG8_HI2(a)) + (PG8_LO2(b) * PG8_LO2(b) + PG8_HI2(b) * PG8_HI2(b)); float s = q2.x + q2.y;
                        s += __shfl_xor(s, 16); s += __shfl_xor(s, 32);
                        if (fq == 0) SSQ[((size_t)row * 4 + (pn - 4) * 2 + bj) * 4 + wc] = s; } }
        } else if (pn < 10) {
            const bool isq = pn < 8; const int head = 4 * (pn - (isq ? 6 : 8)) + wc;
            bf16_t* O = isq ? Q : K; const float* nw = isq ? qnw : knw; const float osc = isq ? C2Q : 1.0f;
            float w[2][2][4], invf[2][4]; int fqo = fq; asm volatile("" : "+v"(fqo));
#pragma unroll
            for (int n = 0; n < 2; ++n)
#pragma unroll
                for (int e = 0; e < 4; ++e) { const int i = 8 * fqo + 4 * n + e; w[0][n][e] = nw[i] * osc; w[1][n][e] = nw[32 + i] * osc;
                    invf[n][e] = __builtin_amdgcn_exp2f(-(float)i * 0.41524101186092029f) * 0.15915494309189535f; }
#pragma unroll
            for (int ai = 0; ai < 2; ++ai)
#pragma unroll
                for (int m = 0; m < 4; ++m) { const int row = row0 + ai * HALF + m * 16; const float p = (float)pos[row];
                    float ss = 0.f;
#pragma unroll
                    for (int bj = 0; bj < 2; ++bj)
#pragma unroll
                        for (int n = 0; n < 2; ++n) { const f32x4 a = acc[ai][bj][m][n]; const f32x2 q2 = PG8_LO2(a) * PG8_LO2(a) + PG8_HI2(a) * PG8_HI2(a); ss += q2.x + q2.y; }
                    ss += __shfl_xor(ss, 16); ss += __shfl_xor(ss, 32);
                    const float rstd = __builtin_amdgcn_rsqf(ss * (1.0f / 64.0f) + 1e-6f);
                    f32x4 o0[2], o1[2];
#pragma unroll
                    for (int n = 0; n < 2; ++n) { f32x2 oa[2], ob[2];
#pragma unroll
                        for (int h2 = 0; h2 < 2; ++h2) { const int e = 2 * h2;
                            const f32x2 rev2 = (f32x2){p, p} * (f32x2){invf[n][e], invf[n][e + 1]};
                            const float r0 = __builtin_amdgcn_fractf(rev2.x), r1 = __builtin_amdgcn_fractf(rev2.y);
                            const f32x2 sn = {__builtin_amdgcn_sinf(r0), __builtin_amdgcn_sinf(r1)}, cs = {__builtin_amdgcn_cosf(r0), __builtin_amdgcn_cosf(r1)};
                            const f32x2 rs2 = {rstd, rstd};
                            const f32x2 a = (f32x2){acc[ai][0][m][n][e], acc[ai][0][m][n][e + 1]} * rs2 * (f32x2){w[0][n][e], w[0][n][e + 1]};
                            const f32x2 b = (f32x2){acc[ai][1][m][n][e], acc[ai][1][m][n][e + 1]} * rs2 * (f32x2){w[1][n][e], w[1][n][e + 1]};
                            oa[h2] = a * cs - b * sn; ob[h2] = b * cs + a * sn; }
                        o0[n] = PG8_CAT4(oa[0], oa[1]); o1[n] = PG8_CAT4(ob[0], ob[1]); }
                    if (isq) { bf16_t* op = O + (size_t)row * 512 + 64 * head + 8 * fq; store8(op, o0[0], o0[1]); store8(op + 32, o1[0], o1[1]); }
                    else {
                        const int bb = row >> 11, sq = row & 2047; bf16_t* op = O + ((size_t)((bb * 8 + head) * 32 + (sq >> 6)) << 12) + fq * 512 + (sq & 63) * 8;
                        store8(op, o0[0], o0[1]); store8(op + 4 * 512, o1[0], o1[1]); } }
        } else {
            const bool sil = pn >= 12; bf16_t* O = sil ? SZB : VB; const int cbase = (pn - (sil ? 12 : 10)) * 256 + wc * 32 + 8 * fq + (u.half > 0 ? 128 : 0);
            const int nbj = (u.half >= 0) ? 1 : 2;
#pragma unroll
            for (int ai = 0; ai < 2; ++ai)
#pragma unroll
                for (int m = 0; m < 4; ++m) { const int row = row0 + ai * HALF + m * 16;
#pragma unroll
                    for (int bj = 0; bj < 2; ++bj) { if (bj >= nbj) continue; f32x4 a = acc[ai][bj][m][0], b = acc[ai][bj][m][1];
                        if (sil) {
#pragma unroll
                            for (int e = 0; e < 1; ++e) { a = silu4(a); b = silu4(b); } }
                        if (sil) store8(O + (size_t)row * 512 + cbase + bj * 128, a, b);
                        else {
                            const int bb = row >> 11, sq = row & 2047, hh = 2 * (pn - 10) + bj;
                            store8(O + ((size_t)((bb * 4 + hh) * 32 + (sq >> 6)) << 13) + (wc * 4 + ((sq & 63) >> 4)) * 512 + (sq & 15) * 32 + 8 * fq, a, b); } } }
        }
    }
};
struct Epi2 {
    static constexpr bool PERM = true, AFTER_DRAIN = false, XPRE = true;
    const float* x; const float* mod; float* out;
    __device__ __forceinline__ void operator()(const f32x4 (&acc)[2][2][4][2], const Unit& u, int wr, int wc, int fr, int fq) const {
        asm volatile("" : "+v"(fr), "+v"(fq));
        const int row0 = u.pm * BM + wr * 64 + fr; const int b = (u.pm * BM) >> 11; const int col0 = u.pn * BM + wc * 32 + 8 * fq;
#pragma unroll
        for (int bj = 0; bj < 2; ++bj) { const f32x4 g0 = *(const f32x4*)(mod + b * 3072 + 2048 + col0 + bj * HALF), g1 = *(const f32x4*)(mod + b * 3072 + 2048 + col0 + bj * HALF + 4);
#pragma unroll
            for (int ai = 0; ai < 2; ++ai)
#pragma unroll
                for (int m = 0; m < 4; ++m) { const size_t off = (size_t)(row0 + ai * HALF + m * 16) * 1024 + col0 + bj * HALF;
                    const f32x4 x0 = __builtin_nontemporal_load((const f32x4*)(x + off)), x1 = __builtin_nontemporal_load((const f32x4*)(x + off + 4));
                    *(f32x4*)(out + off) = x0 + g0 * acc[ai][bj][m][0]; *(f32x4*)(out + off + 4) = x1 + g1 * acc[ai][bj][m][1];
                    if (m & 1) asm volatile("" ::: "memory"); } }
    }
    __device__ __forceinline__ void xpre(int k, const Unit& u, int wr, int wc, int tid, unsigned ldsdst) const {
        const int fr = tid & 15, fq = (tid >> 4) & 3; const int row0 = u.pm * BM + wr * 64 + fr, b = (u.pm * BM) >> 11, col0 = u.pn * BM + wc * 32 + 8 * fq;
        if (k == 0) { const unsigned vo = (unsigned)col0 * 4u; glds16s2nt(vo, vo + 16u, (const void*)(mod + b * 3072 + 2048), ldsdst); }
        else { const int c = k - 1; const unsigned vo = (unsigned)(row0 * 1024 + col0) * 4u; glds16s2nt(vo, vo + 16u, (const void*)(x + (size_t)((c >> 2) * HALF + (c & 3) * 16) * 1024), ldsdst); }
    }
    __device__ __forceinline__ void run(const f32x4 (&acc)[2][2][4][2], const Unit& u, int wr, int wc, int fr, int fq, PG8_LAS unsigned char* lds, unsigned ldsw, int lane, bool pre) const {
        asm volatile("" : "+v"(fr), "+v"(fq));
        const int row0 = u.pm * BM + wr * 64 + fr; const int b = (u.pm * BM) >> 11; const int col0 = u.pn * BM + wc * 32 + 8 * fq;
        constexpr int SLOT[7] = {4, 5, 0, 1, 6, 7, 2};
        const PG8_LAS unsigned char* lp = lds + ldsw + lane * 16;
#pragma unroll
        for (int bj = 0; bj < 2; ++bj) { f32x4 g0, g1;
            if (bj == 0 && pre) { asm volatile("s_waitcnt vmcnt(12)" ::: "memory"); g0 = *(const PG8_LAS f32x4*)(lp + SLOT[0] * HTB); g1 = *(const PG8_LAS f32x4*)(lp + SLOT[0] * HTB + 8192); }
            else { g0 = *(const f32x4*)(mod + b * 3072 + 2048 + col0 + bj * HALF); g1 = *(const f32x4*)(mod + b * 3072 + 2048 + col0 + bj * HALF + 4); }
#pragma unroll
            for (int ai = 0; ai < 2; ++ai)
#pragma unroll
                for (int m = 0; m < 4; ++m) { const size_t off = (size_t)(row0 + ai * HALF + m * 16) * 1024 + col0 + bj * HALF; const int c = ai * 4 + m; f32x4 x0, x1;
                    if (bj == 0 && c < 6 && pre) { asm volatile("s_waitcnt vmcnt(10)" ::: "memory");
                        x0 = *(const PG8_LAS f32x4*)(lp + SLOT[c + 1] * HTB); x1 = *(const PG8_LAS f32x4*)(lp + SLOT[c + 1] * HTB + 8192); }
                    else { x0 = __builtin_nontemporal_load((const f32x4*)(x + off)); x1 = __builtin_nontemporal_load((const f32x4*)(x + off + 4)); }
                    *(f32x4*)(out + off) = x0 + g0 * acc[ai][bj][m][0]; *(f32x4*)(out + off + 4) = x1 + g1 * acc[ai][bj][m][1];
                    if (m & 1) asm volatile("" ::: "memory"); } }
    }
};
struct EpiNull {
    static constexpr bool PERM = true, AFTER_DRAIN = false, XPRE = false;
    __device__ __forceinline__ void operator()(const f32x4 (&acc)[2][2][4][2], const Unit& u, int wr, int wc, int fr, int fq) const {
#pragma unroll
        for (int ai = 0; ai < 2; ++ai)
#pragma unroll
            for (int bj = 0; bj < 2; ++bj)
#pragma unroll
                for (int m = 0; m < 4; ++m)
#pragma unroll
                    for (int n = 0; n < 2; ++n) asm volatile("" :: "v"(acc[ai][bj][m][n]));
    }
};
struct Epi2x2 {
    static constexpr bool PERM = true, AFTER_DRAIN = false, XPRE = false;
    Epi2 e;
    __device__ __forceinline__ void operator()(const f32x4 (&acc)[2][2][4][2], const Unit& u, int wr, int wc, int fr, int fq) const { e(acc, u, wr, wc, fr, fq); asm volatile("" ::: "memory"); e(acc, u, wr, wc, fr, fq); }
};
__device__ __forceinline__ void glds16s2(unsigned voff0, unsigned voff1, const void* sbase, unsigned lds_dst) { unsigned keep;
    asm volatile("s_mov_b32 %0, m0\n\ts_mov_b32 m0, %4\n\ts_nop 0\n\tglobal_load_lds_dwordx4 %1, %3\n\ts_add_u32 m0, %4, 0x2000\n\ts_nop 0\n\tglobal_load_lds_dwordx4 %2, %3\n\ts_mov_b32 m0, %0"
                 : "=&s"(keep) : "v"(voff0), "v"(voff1), "s"(sbase), "s"(lds_dst) : "memory", "scc"); }
__device__ __forceinline__ void glds16s(unsigned voff, const void* sbase, unsigned lds_dst) { unsigned keep;
    asm volatile("s_mov_b32 %0, m0\n\ts_mov_b32 m0, %3\n\ts_nop 0\n\tglobal_load_lds_dwordx4 %1, %2\n\ts_mov_b32 m0, %0" : "=&s"(keep) : "v"(voff), "s"(sbase), "s"(lds_dst) : "memory"); }
template <class Epi, class Sched, bool ALIGN_EPI = false, bool SP2 = false, bool PEEL = false>
__device__ __forceinline__ void gemm_phase(PG8_LAS unsigned char* lds, const Gemm g, const Sched& S, const Epi& E) {
    int tid_ = threadIdx.x; asm volatile("" : "+v"(tid_));
    const int tid = tid_, wid = __builtin_amdgcn_readfirstlane(tid >> 6), lane = tid & 63, wr = wid >> 2, wc = wid & 3, fr = lane & 15, fq = lane >> 4;
    const int K = g.K, nt = K / BK;
    unsigned voffA[2], voffB[2];
#pragma unroll
    for (int i = 0; i < 2; ++i) { int R, C; stage_rc(tid * 16 + i * 8192, R, C); const int Rb = Epi::PERM ? ((R & ~31) + perm32(R & 31)) : R;
        voffA[i] = (unsigned)(R * K + C) * 2u; voffB[i] = (unsigned)(Rb * K + C) * 2u; }
    const size_t kstep = (size_t)(BK * 2);
    const size_t hstep = (size_t)HALF * K * 2;
    const size_t tstep = 2 * hstep;
    const unsigned ldsw = (unsigned)wid * 1024u;
    const unsigned ldsb = (unsigned)(size_t)lds;
    const int aoff = lds_byte(wr * 64 + fr, fq * 8), boff = lds_byte(wc * 32 + fr, fq * 8);
#define PG8_SA(b, h) (((b) * 2 + (h)) * HTB)
#define PG8_SB(b, h) ((4 + (b) * 2 + (h)) * HTB)
#define PG8_STAGE(bufoff, gbase, voff) glds16s2((voff)[0], (voff)[1], (const void*)(gbase), ldsb + (bufoff) + ldsw)
#define PG8_STAGEX(k, bufoff, gbase, voff) do { if constexpr (Epi::XPRE) { if (xl) E.xpre(k, cur, wr, wc, tid, ldsb + (bufoff) + ldsw); else PG8_STAGE(bufoff, gbase, voff); } else PG8_STAGE(bufoff, gbase, voff); } while (0)
#define PG8_LDA(dst, b, h) do { _Pragma("unroll") for (int m = 0; m < 4; ++m) _Pragma("unroll") for (int k = 0; k < 2; ++k) dst[m][k] = *(const PG8_LAS bf16x8*)(lds + PG8_SA(b, h) + aoff + m * 2048 + k * 1024); } while (0)
#define PG8_LDB(dst, b, h) do { _Pragma("unroll") for (int n = 0; n < 2; ++n) _Pragma("unroll") for (int k = 0; k < 2; ++k) dst[n][k] = *(const PG8_LAS bf16x8*)(lds + PG8_SB(b, h) + boff + n * 2048 + k * 1024); } while (0)
#define PG8_MMAZ(ai, bj, At, Bt, Z) do { __builtin_amdgcn_s_setprio(1); _Pragma("unroll") for (int m = 0; m < 4; ++m) _Pragma("unroll") for (int n = 0; n < 2; ++n) _Pragma("unroll") for (int k = 0; k < 2; ++k) \
        acc[ai][bj][m][n] = __builtin_amdgcn_mfma_f32_16x16x32_bf16(Bt[n][k], At[m][k], ((Z) && k == 0) ? (f32x4){0.f, 0.f, 0.f, 0.f} : acc[ai][bj][m][n], 0, 0, 0); __builtin_amdgcn_s_setprio(0); } while (0)
#define PG8_MMA(ai, bj, At, Bt) PG8_MMAZ(ai, bj, At, Bt, false)
#define PG8_WAIT_V(n) asm volatile("s_waitcnt vmcnt(" #n ")" ::: "memory")
#define PG8_WAIT_L(n) asm volatile("s_waitcnt lgkmcnt(" #n ")" ::: "memory")
#define PG8_BAR __builtin_amdgcn_s_barrier()
#define PG8_SCHED __builtin_amdgcn_sched_barrier(0)
    Unit cur, nxt; int ui = 0;
    if (!S.next(0, cur)) return;
    f32x4 acc[2][2][4][2];
    if constexpr (!(SP2 && PEEL)) {
#pragma unroll
    for (int a = 0; a < 2; ++a)
#pragma unroll
        for (int b = 0; b < 2; ++b)
#pragma unroll
            for (int m = 0; m < 4; ++m)
#pragma unroll
                for (int n = 0; n < 2; ++n) acc[a][b][m][n] = (f32x4){0.f, 0.f, 0.f, 0.f};
    }
    bf16x8 At[4][2], B0[2][2], B1[2][2];
    const char* cA = (const char*)g.A + (size_t)cur.pm * tstep; const char* cB = (const char*)g.Bt + (size_t)cur.pn * tstep + (cur.half > 0 ? hstep : 0);
    S.a_ready(cur);
    if constexpr (SP2) {
        PG8_STAGE(PG8_SB(0, 0), cB, voffB); PG8_STAGE(PG8_SB(0, 1), cB + hstep, voffB); PG8_STAGE(PG8_SA(0, 0), cA, voffA); PG8_STAGE(PG8_SA(0, 1), cA + hstep, voffA);
        if (wr == 1) PG8_BAR;
        PG8_WAIT_V(2); PG8_BAR;
        PG8_STAGE(PG8_SB(1, 0), cB + kstep, voffB); PG8_STAGE(PG8_SA(1, 0), cA + kstep, voffA); PG8_STAGE(PG8_SB(1, 1), cB + hstep + kstep, voffB);
        PG8_WAIT_V(6); PG8_BAR;
    } else {
        PG8_STAGE(PG8_SB(0, 0), cB, voffB); PG8_STAGE(PG8_SA(0, 0), cA, voffA); PG8_STAGE(PG8_SB(0, 1), cB + hstep, voffB); PG8_STAGE(PG8_SA(0, 1), cA + hstep, voffA);
        if (wr == 1) PG8_BAR;
        PG8_WAIT_V(4); PG8_BAR;
        PG8_STAGE(PG8_SB(1, 0), cB + kstep, voffB); PG8_STAGE(PG8_SA(1, 0), cA + kstep, voffA); PG8_STAGE(PG8_SB(1, 1), cB + hstep + kstep, voffB);
        PG8_WAIT_V(6); PG8_BAR;
    }
    for (;;) {
        const bool has_next = S.next(ui + 1, nxt);
        const char* nA = has_next ? (const char*)g.A + (size_t)nxt.pm * tstep : cA; const char* nB = has_next ? (const char*)g.Bt + (size_t)nxt.pn * tstep + (nxt.half > 0 ? hstep : 0) : cB;
        const bool fullu = cur.half < 0;
#define PG8_KITER(ZF) do { \
            const bool last = (t == nt - 2); const bool xl = Epi::XPRE && last && !has_next; \
            const char* a1 = cA + (size_t)(t + 1) * kstep; \
            const char* a2 = last ? nA : cA + (size_t)(t + 2) * kstep; const char* b2 = last ? nB : cB + (size_t)(t + 2) * kstep; \
            const char* a3 = a2 + kstep; const char* b3 = b2 + kstep; \
            if (last && has_next) S.a_ready(nxt); \
            if constexpr (Sched::HAS_MID) { if (t == 4) S.mid(ui, tid); } \
            if constexpr (SP2) { \
            PG8_LDB(B0, 0, 0); PG8_LDB(B1, 0, 1); PG8_SCHED; PG8_LDA(At, 0, 0); PG8_STAGE(PG8_SA(1, 1), a1 + hstep, voffA); \
            PG8_WAIT_V(8); PG8_WAIT_L(0); PG8_BAR; PG8_MMAZ(0, 0, At, B0, ZF); PG8_MMAZ(0, 1, At, B1, ZF); PG8_BAR; PG8_SCHED; \
            PG8_LDA(At, 0, 1); PG8_STAGEX(0, PG8_SB(0, 0), b2, voffB); PG8_STAGEX(1, PG8_SB(0, 1), b2 + hstep, voffB); PG8_STAGEX(2, PG8_SA(0, 0), a2, voffA); \
            PG8_WAIT_V(8); PG8_WAIT_L(0); PG8_BAR; PG8_MMAZ(1, 0, At, B0, ZF); PG8_MMAZ(1, 1, At, B1, ZF); PG8_BAR; PG8_SCHED; \
            PG8_LDB(B0, 1, 0); PG8_LDB(B1, 1, 1); PG8_SCHED; PG8_LDA(At, 1, 0); PG8_STAGEX(3, PG8_SA(0, 1), a2 + hstep, voffA); \
            PG8_WAIT_V(8); PG8_WAIT_L(0); PG8_BAR; PG8_MMA(0, 0, At, B0); PG8_MMA(0, 1, At, B1); PG8_BAR; PG8_SCHED; \
            PG8_LDA(At, 1, 1); PG8_STAGEX(4, PG8_SB(1, 0), b3, voffB); PG8_STAGEX(5, PG8_SB(1, 1), b3 + hstep, voffB); PG8_STAGEX(6, PG8_SA(1, 0), a3, voffA); \
            if (xl) { PG8_WAIT_V(14); } else { PG8_WAIT_V(8); } PG8_WAIT_L(0); PG8_BAR; PG8_MMA(1, 0, At, B0); PG8_MMA(1, 1, At, B1); PG8_BAR; PG8_SCHED; \
            } else { \
            PG8_LDB(B0, 0, 0); PG8_SCHED; PG8_LDA(At, 0, 0); PG8_STAGE(PG8_SA(1, 1), a1 + hstep, voffA); \
            PG8_WAIT_L(8); PG8_BAR; PG8_WAIT_L(0); PG8_MMA(0, 0, At, B0); PG8_BAR; PG8_SCHED; \
            PG8_LDB(B1, 0, 1); PG8_STAGE(PG8_SB(0, 0), b2, voffB); \
            PG8_BAR; PG8_WAIT_L(0); PG8_MMA(0, 1, At, B1); PG8_BAR; \
            PG8_LDA(At, 0, 1); PG8_STAGE(PG8_SA(0, 0), a2, voffA); \
            PG8_BAR; PG8_WAIT_L(0); PG8_MMA(1, 0, At, B0); PG8_BAR; PG8_SCHED; \
            PG8_STAGE(PG8_SB(0, 1), b2 + hstep, voffB); \
            PG8_WAIT_V(6); PG8_BAR; PG8_MMA(1, 1, At, B1); PG8_BAR; \
            PG8_LDB(B0, 1, 0); PG8_SCHED; PG8_LDA(At, 1, 0); PG8_STAGE(PG8_SA(0, 1), a2 + hstep, voffA); \
            PG8_WAIT_L(8); PG8_BAR; PG8_WAIT_L(0); PG8_MMA(0, 0, At, B0); PG8_BAR; PG8_SCHED; \
            PG8_LDB(B1, 1, 1); PG8_STAGE(PG8_SB(1, 0), b3, voffB); \
            PG8_BAR; PG8_WAIT_L(0); PG8_MMA(0, 1, At, B1); PG8_BAR; \
            PG8_LDA(At, 1, 1); PG8_STAGE(PG8_SA(1, 0), a3, voffA); \
            PG8_BAR; PG8_WAIT_L(0); PG8_MMA(1, 0, At, B0); PG8_BAR; PG8_SCHED; \
            PG8_STAGE(PG8_SB(1, 1), b3 + hstep, voffB); \
            PG8_WAIT_V(6); PG8_BAR; PG8_MMA(1, 1, At, B1); PG8_BAR; \
            } \
        } while (0)
        if constexpr (SP2 && PEEL) { int t = 0; PG8_KITER(true); _Pragma("unroll 1") for (t = 2; t < nt; t += 2) PG8_KITER(false); }
        else { for (int t = 0; t < nt; t += 2) PG8_KITER(false); }
#undef PG8_KITER
        if constexpr (ALIGN_EPI) { if (wr == 0) PG8_BAR; }
        if constexpr (!Epi::AFTER_DRAIN) { int tl = tid; asm volatile("" : "+v"(tl)); if constexpr (Epi::XPRE) E.run(acc, cur, wr, wc, tl & 15, (tl >> 4) & 3, lds, ldsw, tl & 63, !has_next); else E(acc, cur, wr, wc, tl & 15, (tl >> 4) & 3); S.done(cur); }
        if (!has_next) break;
        if constexpr (!(SP2 && PEEL)) {
#pragma unroll
        for (int a = 0; a < 2; ++a)
#pragma unroll
            for (int b = 0; b < 2; ++b)
#pragma unroll
                for (int m = 0; m < 4; ++m)
#pragma unroll
                    for (int n = 0; n < 2; ++n) acc[a][b][m][n] = (f32x4){0.f, 0.f, 0.f, 0.f};
        }
        cur = nxt; cA = nA; cB = nB; ++ui;
        if constexpr (ALIGN_EPI) { if (wr == 1) PG8_BAR; }
    }
    PG8_WAIT_V(0);
    if constexpr (!ALIGN_EPI) { if (wr == 0) PG8_BAR; }
    PG8_BAR;
    if constexpr (Epi::AFTER_DRAIN) { E.fused(acc, cur, wr, wc, fr, fq, lds, wid, lane); S.done(cur); }
#undef PG8_SA
#undef PG8_SB
#undef PG8_STAGE
#undef PG8_LDA
#undef PG8_LDB
#undef PG8_MMA
#undef PG8_WAIT_V
#undef PG8_WAIT_L
#undef PG8_BAR
#undef PG8_SCHED
}
}
namespace att {
typedef unsigned short bf16_t;
typedef short bf16x8 __attribute__((ext_vector_type(8)));
typedef short s16x4 __attribute__((ext_vector_type(4)));
typedef short v4i16_t __attribute__((ext_vector_type(4)));
typedef float f32x4 __attribute__((ext_vector_type(4)));
typedef float f32x16 __attribute__((ext_vector_type(16)));
typedef unsigned u32x4 __attribute__((ext_vector_type(4)));
#define ALAS __attribute__((address_space(3)))
constexpr int KOFF0 = 0, KOFF1 = 8192, VOFF = 16384, BUFB = 32768;
constexpr int XOFF = 65536, XROW = 132;
constexpr int WSF_OFF = XOFF + 128 * XROW * 4;
constexpr int ATT_LDS_END = WSF_OFF + 8 * 256;
__device__ __forceinline__ int crow(int r, int hi) { return (r & 3) + 8 * (r >> 2) + 4 * hi; }
__device__ __forceinline__ unsigned cvtpk(float lo, float hi) { typedef float f2 __attribute__((ext_vector_type(2))); typedef __bf16 b2 __attribute__((ext_vector_type(2))); f2 v = {lo, hi}; b2 b = __builtin_convertvector(v, b2); return __builtin_bit_cast(unsigned, b); }
__device__ __forceinline__ s16x4 vtr(const ALAS unsigned char* p) { return __builtin_bit_cast(s16x4, __builtin_amdgcn_ds_read_tr16_b64_v4i16((ALAS v4i16_t*)p)); }
__device__ __forceinline__ float bf2f(unsigned short h) { return __uint_as_float(((unsigned)h) << 16); }
__device__ __forceinline__ void st16_wt(void* p, u32x4 v) { asm volatile("global_store_dwordx4 %0, %1, off sc1\n\ts_nop 1" :: "v"(p), "v"(v) : "memory"); }
#define AMFMA(a, b, c) __builtin_amdgcn_mfma_f32_32x32x16_bf16(a, b, c, 0, 0, 0)
#define LBAR() asm volatile("s_waitcnt lgkmcnt(0)\n\ts_barrier" ::: "memory")

constexpr int GM_TOFF = 32768, GM_TROW = 132;
struct GmLoads { bf16x8 vv[4]; f32x4 qq[4], w0[4], w1[4]; bf16x8 af[8]; bf16x8 gv[4]; float bsv[16]; };
__device__ __forceinline__ void gm_load(GmLoads& L, int tid, int gi, const bf16_t* Wsb, const bf16_t* VA, const float* SSQ, const float* sgw, const bf16_t* G, const float* bs) {
    const int b = gi >> 6, n = (gi >> 2) & 15, hA = gi & 3; const size_t R0 = (size_t)b * 2048 + 128 * n;
    const int lane = tid & 63, r32 = lane & 31, hi = lane >> 5, tb = (tid >> 6) & 3;
#pragma unroll
    for (int i = 0; i < 4; ++i) { const int cidx = tid + 512 * i, s = cidx >> 4, c = 8 * (cidx & 15);
        L.vv[i] = __builtin_nontemporal_load((const bf16x8*)(VA + (R0 + s) * 512 + 128 * hA + c)); L.qq[i] = __builtin_nontemporal_load((const f32x4*)(SSQ + ((R0 + s) * 4 + hA) * 4));
        L.w0[i] = *(const f32x4*)(sgw + 128 * hA + c); L.w1[i] = *(const f32x4*)(sgw + 128 * hA + c + 4);
        L.gv[i] = __builtin_nontemporal_load((const bf16x8*)(G + (R0 + s) * 512 + 128 * hA + c)); }
    const bf16_t* wrow = Wsb + (size_t)hA * 16384 + (32 * tb + r32) * 128 + 8 * hi;
#pragma unroll
    for (int ks = 0; ks < 8; ++ks) L.af[ks] = (ks < 2 * (tb + 1)) ? *(const bf16x8*)(wrow + 16 * ks) : (bf16x8){0, 0, 0, 0, 0, 0, 0, 0};
#pragma unroll
    for (int r = 0; r < 16; ++r) L.bsv[r] = bs[128 * hA + 32 * tb + crow(r, hi)];
}
__device__ __forceinline__ void gm_stage(ALAS unsigned char* lds, const GmLoads& L, int tid) {
#pragma unroll
    for (int i = 0; i < 4; ++i) { const int cidx = tid + 512 * i, s = cidx >> 4, c = 8 * (cidx & 15);
        const float rstd = __builtin_amdgcn_rsqf(((L.qq[i][0] + L.qq[i][1]) + (L.qq[i][2] + L.qq[i][3])) * (1.0f / 128.0f) + 1e-6f);
        float y[8];
#pragma unroll
        for (int e = 0; e < 4; ++e) { y[e] = bf2f((unsigned short)L.vv[i][e]) * rstd * L.w0[i][e]; y[4 + e] = bf2f((unsigned short)L.vv[i][4 + e]) * rstd * L.w1[i][e]; }
        u32x4 pk; pk.x = cvtpk(y[0], y[1]); pk.y = cvtpk(y[2], y[3]); pk.z = cvtpk(y[4], y[5]); pk.w = cvtpk(y[6], y[7]);
        *(ALAS u32x4*)(lds + ((c >> 5) * 8 + (s >> 4)) * 1024 + (s & 15) * 64 + (c & 31) * 2) = pk; }
}
__device__ __forceinline__ void gm_mma(ALAS unsigned char* lds, const GmLoads& L, int tid, int gi, const float* bs) {
    const int lane = tid & 63, r32 = lane & 31, hi = lane >> 5, tb = (tid >> 6) & 3, ch = tid >> 8, hA = gi & 3;
    f32x16 acc[2]; acc[0] = f32x16{}; acc[1] = f32x16{};
    const ALAS unsigned char* vp = lds + ((lane >> 4) & 1) * 32 + (lane & 3) * 8 + (8 * hi + ((lane & 15) >> 2)) * 64;
#pragma unroll
    for (int ks = 0; ks < 8; ++ks) { if (ks < 2 * (tb + 1)) {
#pragma unroll
        for (int cbi = 0; cbi < 2; ++cbi) { const int cb = 2 * ch + cbi; const s16x4 lo = vtr(vp + (cb * 8 + ks) * 1024), hh = vtr(vp + (cb * 8 + ks) * 1024 + 256);
            const bf16x8 vf = (bf16x8){lo[0], lo[1], lo[2], lo[3], hh[0], hh[1], hh[2], hh[3]};
            acc[cbi] = AMFMA(L.af[ks], vf, acc[cbi]); } } }
    ALAS float* T = (ALAS float*)(lds + GM_TOFF);
#pragma unroll
    for (int r = 0; r < 16; ++r) { const int t = 32 * tb + crow(r, hi); const float bias = L.bsv[r];
        T[t * GM_TROW + 32 * (2 * ch) + r32] = acc[0][r] + bias; T[t * GM_TROW + 32 * (2 * ch + 1) + r32] = acc[1][r] + bias; }
}
__device__ __forceinline__ void gm_epi(ALAS unsigned char* lds, const GmLoads& L, int tid, int gi, bf16_t* MIXED) {
    const int b = gi >> 6, n = (gi >> 2) & 15, hA = gi & 3; const size_t R0 = (size_t)b * 2048 + 128 * n;
    const ALAS float* T = (const ALAS float*)(lds + GM_TOFF);
#pragma unroll
    for (int i = 0; i < 4; ++i) { const int cidx = tid + 512 * i, t = cidx >> 4, c = 8 * (cidx & 15);
        const f32x4 m0 = *(const ALAS f32x4*)(T + t * GM_TROW + c), m1 = *(const ALAS f32x4*)(T + t * GM_TROW + c + 4);
        float y[8];
#pragma unroll
        for (int e = 0; e < 4; ++e) { y[e] = bf2f((unsigned short)L.gv[i][e]) * m0[e]; y[4 + e] = bf2f((unsigned short)L.gv[i][4 + e]) * m1[e]; }
        u32x4 pk; pk.x = cvtpk(y[0], y[1]); pk.y = cvtpk(y[2], y[3]); pk.z = cvtpk(y[4], y[5]); pk.w = cvtpk(y[6], y[7]);
        *(u32x4*)(MIXED + (R0 + t) * 1024 + 128 * hA + c) = pk; }
}
__device__ __forceinline__ void gmlp_pair(ALAS unsigned char* lds, int gi0, int gi1, const bf16_t* Wsb, const bf16_t* VA, const float* SSQ, const float* sgw, const float* bs, const bf16_t* G, bf16_t* MIXED) {
    int tid = threadIdx.x; asm volatile("" : "+v"(tid));
    GmLoads A, B;
    gm_load(A, tid, gi0, Wsb, VA, SSQ, sgw, G, bs);
    gm_stage(lds, A, tid);
    LBAR();
    gm_load(B, tid, gi1, Wsb, VA, SSQ, sgw, G, bs);
    gm_mma(lds, A, tid, gi0, bs);
    LBAR();
    gm_epi(lds, A, tid, gi0, MIXED);
    gm_stage(lds, B, tid);
    LBAR();
    gm_mma(lds, B, tid, gi1, bs);
    LBAR();
    gm_epi(lds, B, tid, gi1, MIXED);
    LBAR();
}
struct GmHead { f32x4 w0, w1; bf16x8 af[8]; float bsv[16]; };
struct GmItem { bf16x8 vv[4]; f32x4 qq[4]; bf16x8 gv[4]; };
__device__ __forceinline__ void gmh_load(GmHead& H, int tid, int hA, const bf16_t* Wsb, const float* sgw, const float* bs) {
    const int lane = tid & 63, r32 = lane & 31, hi = lane >> 5, tb = (tid >> 6) & 3, c = 8 * (tid & 15);
    H.w0 = *(const f32x4*)(sgw + 128 * hA + c); H.w1 = *(const f32x4*)(sgw + 128 * hA + c + 4);
    const bf16_t* wrow = Wsb + (size_t)hA * 16384 + (32 * tb + r32) * 128 + 8 * hi;
#pragma unroll
    for (int ks = 0; ks < 8; ++ks) H.af[ks] = (ks < 2 * (tb + 1)) ? *(const bf16x8*)(wrow + 16 * ks) : (bf16x8){0, 0, 0, 0, 0, 0, 0, 0};
#pragma unroll
    for (int r = 0; r < 16; ++r) H.bsv[r] = bs[128 * hA + 32 * tb + crow(r, hi)];
}
__device__ __forceinline__ void gmi_load(GmItem& L, int tid, int gi, const bf16_t* VA, const float* SSQ, const bf16_t* G) {
    const int b = gi >> 6, n = (gi >> 2) & 15, hA = gi & 3; const size_t R0 = (size_t)b * 2048 + 128 * n;
#pragma unroll
    for (int i = 0; i < 4; ++i) { const int cidx = tid + 512 * i, s = cidx >> 4, c = 8 * (cidx & 15);
        L.vv[i] = __builtin_nontemporal_load((const bf16x8*)(VA + (R0 + s) * 512 + 128 * hA + c)); L.qq[i] = __builtin_nontemporal_load((const f32x4*)(SSQ + ((R0 + s) * 4 + hA) * 4));
        L.gv[i] = __builtin_nontemporal_load((const bf16x8*)(G + (R0 + s) * 512 + 128 * hA + c)); }
}
__device__ __forceinline__ void gmi_stage(ALAS unsigned char* lds, const GmItem& L, const GmHead& H, int tid) {
#pragma unroll
    for (int i = 0; i < 4; ++i) { const int cidx = tid + 512 * i, s = cidx >> 4, c = 8 * (cidx & 15);
        const float rstd = __builtin_amdgcn_rsqf(((L.qq[i][0] + L.qq[i][1]) + (L.qq[i][2] + L.qq[i][3])) * (1.0f / 128.0f) + 1e-6f);
        float y[8];
#pragma unroll
        for (int e = 0; e < 4; ++e) { y[e] = bf2f((unsigned short)L.vv[i][e]) * rstd * H.w0[e]; y[4 + e] = bf2f((unsigned short)L.vv[i][4 + e]) * rstd * H.w1[e]; }
        u32x4 pk; pk.x = cvtpk(y[0], y[1]); pk.y = cvtpk(y[2], y[3]); pk.z = cvtpk(y[4], y[5]); pk.w = cvtpk(y[6], y[7]);
        *(ALAS u32x4*)(lds + ((c >> 5) * 8 + (s >> 4)) * 1024 + (s & 15) * 64 + (c & 31) * 2) = pk; }
}
__device__ __forceinline__ void gmh_mma(ALAS unsigned char* lds, const GmHead& H, int tid) {
    const int lane = tid & 63, r32 = lane & 31, hi = lane >> 5, tb = (tid >> 6) & 3, ch = tid >> 8;
    f32x16 acc[2]; acc[0] = f32x16{}; acc[1] = f32x16{};
    const ALAS unsigned char* vp = lds + ((lane >> 4) & 1) * 32 + (lane & 3) * 8 + (8 * hi + ((lane & 15) >> 2)) * 64;
#pragma unroll
    for (int ks = 0; ks < 8; ++ks) { if (ks < 2 * (tb + 1)) {
#pragma unroll
        for (int cbi = 0; cbi < 2; ++cbi) { const int cb = 2 * ch + cbi; const s16x4 lo = vtr(vp + (cb * 8 + ks) * 1024), hh = vtr(vp + (cb * 8 + ks) * 1024 + 256);
            const bf16x8 vf = (bf16x8){lo[0], lo[1], lo[2], lo[3], hh[0], hh[1], hh[2], hh[3]};
            acc[cbi] = AMFMA(H.af[ks], vf, acc[cbi]); } } }
    ALAS float* T = (ALAS float*)(lds + GM_TOFF);
#pragma unroll
    for (int r = 0; r < 16; ++r) { const int t = 32 * tb + crow(r, hi); const float bias = H.bsv[r];
        T[t * GM_TROW + 32 * (2 * ch) + r32] = acc[0][r] + bias; T[t * GM_TROW + 32 * (2 * ch + 1) + r32] = acc[1][r] + bias; }
}
__device__ __forceinline__ void gmi_epi(ALAS unsigned char* lds, const GmItem& L, int tid, int gi, bf16_t* MIXED) {
    const int b = gi >> 6, n = (gi >> 2) & 15, hA = gi & 3; const size_t R0 = (size_t)b * 2048 + 128 * n;
    const ALAS float* T = (const ALAS float*)(lds + GM_TOFF);
#pragma unroll
    for (int i = 0; i < 4; ++i) { const int cidx = tid + 512 * i, t = cidx >> 4, c = 8 * (cidx & 15);
        const f32x4 m0 = *(const ALAS f32x4*)(T + t * GM_TROW + c), m1 = *(const ALAS f32x4*)(T + t * GM_TROW + c + 4);
        float y[8];
#pragma unroll
        for (int e = 0; e < 4; ++e) { y[e] = bf2f((unsigned short)L.gv[i][e]) * m0[e]; y[4 + e] = bf2f((unsigned short)L.gv[i][4 + e]) * m1[e]; }
        u32x4 pk; pk.x = cvtpk(y[0], y[1]); pk.y = cvtpk(y[2], y[3]); pk.z = cvtpk(y[4], y[5]); pk.w = cvtpk(y[6], y[7]);
        *(u32x4*)(MIXED + (R0 + t) * 1024 + 128 * hA + c) = pk; }
}
__device__ __forceinline__ void gmlp_head4(ALAS unsigned char* lds, int gi0, const bf16_t* Wsb, const bf16_t* VA, const float* SSQ, const float* sgw, const float* bs, const bf16_t* G, bf16_t* MIXED) {
    int tid = threadIdx.x; asm volatile("" : "+v"(tid));
    GmHead H; GmItem A, B;
    gmi_load(A, tid, gi0, VA, SSQ, G);
    gmh_load(H, tid, gi0 & 3, Wsb, sgw, bs);
    gmi_stage(lds, A, H, tid);
    LBAR();
    gmi_load(B, tid, gi0 + 4, VA, SSQ, G);
    gmh_mma(lds, H, tid);
    LBAR();
    gmi_epi(lds, A, tid, gi0, MIXED);
    gmi_stage(lds, B, H, tid);
    LBAR();
    gmi_load(A, tid, gi0 + 8, VA, SSQ, G);
    gmh_mma(lds, H, tid);
    LBAR();
    gmi_epi(lds, B, tid, gi0 + 4, MIXED);
    gmi_stage(lds, A, H, tid);
    LBAR();
    gmi_load(B, tid, gi0 + 12, VA, SSQ, G);
    gmh_mma(lds, H, tid);
    LBAR();
    gmi_epi(lds, A, tid, gi0 + 8, MIXED);
    gmi_stage(lds, B, H, tid);
    LBAR();
    gmh_mma(lds, H, tid);
    LBAR();
    gmi_epi(lds, B, tid, gi0 + 12, MIXED);
    LBAR();
}
#undef AMFMA
}
namespace att2 {
using att::bf16_t; using att::bf16x8; using att::s16x4; using att::f32x4; using att::f32x16; using att::u32x4; using att::crow; using att::cvtpk; using att::vtr; using att::bf2f;
constexpr int SLOTB = 16384, NSLOT = 3;
constexpr int LDS_K = 0, LDS_V = NSLOT * SLOTB, RING_END = 2 * NSLOT * SLOTB;
constexpr int XOFF = LDS_V + SLOTB, XROW = 132;
constexpr int WSF_OFF = XOFF + 128 * XROW * 4, ATT2_LDS_END = WSF_OFF + 8 * 256;
#define SBAR() __builtin_amdgcn_sched_barrier(0)
#define PIN(x) asm volatile("" : "+v"(x))
#define MFMA32(a, b, c) __builtin_amdgcn_mfma_f32_32x32x16_bf16(a, b, c, 0, 0, 0)
#define WAIT_BAR(N) asm volatile("s_waitcnt vmcnt(" #N ") lgkmcnt(0)\n\ts_barrier" ::: "memory")
__device__ __forceinline__ void glds16(unsigned voff, const void* sbase, unsigned lds_dst) { unsigned keep;
    asm volatile("s_mov_b32 %0, m0\n\ts_mov_b32 m0, %3\n\ts_nop 0\n\tglobal_load_lds_dwordx4 %1, %2\n\ts_mov_b32 m0, %0" : "=&s"(keep) : "v"(voff), "s"(sbase), "s"(lds_dst) : "memory"); }
typedef const ALAS unsigned char* lptr;
__device__ __forceinline__ void cmask(f32x16& p0, f32x16& p1, int rel, int qrel, int hi) {
    int thr = qrel - 64 * rel - 4 * hi; asm volatile("" : "+v"(thr));
#pragma unroll
    for (int r = 0; r < 16; ++r) { const int c = (r & 3) + 8 * (r >> 2); if (c > thr) p0[r] = -INFINITY; if (c + 32 > thr) p1[r] = -INFINITY; }
}

__device__ __forceinline__ void attn_pair(ALAS unsigned char* lds, unsigned lds0, int b, int h, int qbA, int qbB, const bf16_t* Q, const bf16_t* __restrict__ K, const bf16_t* __restrict__ V, const bf16_t* SZB, bf16_t* MIXED, const float* subw, float lam, unsigned* c3, unsigned* tmo) {
    int tid_ = threadIdx.x; asm volatile("" : "+v"(tid_));
    const int tid = tid_, lane = tid & 63, r32 = lane & 31, hi = lane >> 5;
    const int wid = __builtin_amdgcn_readfirstlane(tid >> 6), g = wid & 3, sh = wid >> 2;
    if (sh) __builtin_amdgcn_s_setprio(1);
    const size_t rowbase = (size_t)b * 2048;
    const bf16_t* kbase = K + ((size_t)((b * 8 + 2 * h) * 32) << 12);
    const bf16_t* vbase = V + ((size_t)((b * 4 + h) * 32) << 13);
    const unsigned koff = (unsigned)(wid * 1024 + lane * 16);
    const unsigned voff = (unsigned)(((wid >> 2) * 4 + (wid & 3)) * 1024 + lane * 16);
    const unsigned kdst = lds0 + LDS_K + wid * 1024, vdst = lds0 + LDS_V + ((wid >> 2) * 4 + (wid & 3)) * 1024;
#define DMA_K(t, slot) do { const bf16_t* s_ = kbase + ((size_t)(t) << 12); glds16(koff, s_, (unsigned)__builtin_amdgcn_readfirstlane(kdst + (slot))); glds16(koff, s_ + (32 << 12), (unsigned)__builtin_amdgcn_readfirstlane(kdst + (slot) + 8192)); } while (0)
#define DMA_V(t, slot) do { const bf16_t* s_ = vbase + ((size_t)(t) << 13); glds16(voff, s_, (unsigned)__builtin_amdgcn_readfirstlane(vdst + (slot))); glds16(voff, s_ + 4096, (unsigned)__builtin_amdgcn_readfirstlane(vdst + (slot) + 8192)); } while (0)
    const lptr kp0 = lds + LDS_K + sh * 8192 + hi * 1024 + r32 * 16;
    const lptr vp0 = lds + LDS_V + ((lane >> 4) & 1) * 32 + (lane & 3) * 8 + (4 * hi + ((lane & 15) >> 2)) * 64;
#define ISSUE(qb_, qq_) do { DMA_K(0, 0); DMA_V(0, 0); DMA_K(1, SLOTB); \
        const bf16_t* Qw_ = Q + (rowbase + (qb_) * 128 + 32 * g + r32) * 512 + 64 * (2 * h + sh); \
        _Pragma("unroll") for (int d0 = 0; d0 < 4; ++d0) qq_[d0] = __builtin_nontemporal_load((const bf16x8*)(Qw_ + 16 * d0 + 8 * hi)); \
        if ((qb_) > 0) DMA_K(2, 2 * SLOTB); } while (0)
    bf16x8 qr[4], qn[4];
    ISSUE(qbA, qr);
#pragma unroll 1
    for (int u = 0; u < 2; ++u) {
    const int qb = u ? qbB : qbA; const int q0 = qb * 128; const int NT = 2 * (qb + 1);
    f32x16 o[4]; o[0] = f32x16{}; o[1] = f32x16{}; o[2] = f32x16{}; o[3] = f32x16{};
    const f32x16 z16 = f32x16{};
    float l_reg = 0.f; const int qrel = 32 * g + r32;
    f32x16 pA0, pA1, pB0, pB1; bf16x8 kf[8]; u32x4 pw0, pw1, pw2, pw3;
    int sl_prev = 0, sl_cur = 0, sl_next = SLOTB;
#define ROT() do { sl_prev = sl_cur; sl_cur = sl_next; sl_next = (sl_next == (NSLOT - 1) * SLOTB) ? 0 : sl_next + SLOTB; } while (0)
#define KLD(i, base) kf[i] = *(const ALAS bf16x8*)((base) + ((i) >> 1) * 2048 + ((i) & 1) * 512)
    sl_prev = 0; sl_cur = 0; sl_next = SLOTB; l_reg = 0.f; o[0] = f32x16{}; o[1] = f32x16{}; o[2] = f32x16{}; o[3] = f32x16{};
    if (u) { WAIT_BAR(0); } else if (NT > 2) { WAIT_BAR(6); } else { WAIT_BAR(4); }
    {
#pragma unroll
        for (int i = 0; i < 8; ++i) KLD(i, kp0);
        pA0 = MFMA32(kf[0], qr[0], z16); pA1 = MFMA32(kf[1], qr[0], z16);
#pragma unroll
        for (int d0 = 1; d0 < 4; ++d0) { pA0 = MFMA32(kf[2 * d0], qr[d0], pA0); pA1 = MFMA32(kf[2 * d0 + 1], qr[d0], pA1); }
        if (qb == 0) cmask(pA0, pA1, 0, qrel, hi);
#pragma unroll
        for (int r = 0; r < 16; ++r) { pA0[r] = __builtin_amdgcn_exp2f(pA0[r]); pA1[r] = __builtin_amdgcn_exp2f(pA1[r]); }
    }
    WAIT_BAR(0);
    if (NT > 3) DMA_K(3, 0);
    DMA_V(1, SLOTB);
    ROT();
#pragma unroll
    for (int i = 0; i < 8; ++i) KLD(i, kp0 + sl_cur);
    if (NT > 3) { WAIT_BAR(4); } else { WAIT_BAR(0); }
#define PKW(P, B) cvtpk(P[B], P[B + 1])
#define PAF(k) __builtin_bit_cast(bf16x8, pw##k)
#define VRD(j) const s16x4 vl##j = vtr(vp_ + ((((j) & 3) * 4 + ((j) >> 2)) * 1024)), vh##j = vtr(vp_ + ((((j) & 3) * 4 + ((j) >> 2)) * 1024 + 512))
#define VFR(j) (bf16x8){vl##j[0], vl##j[1], vl##j[2], vl##j[3], vh##j[0], vh##j[1], vh##j[2], vh##j[3]}
#define GAPA(MF, A0, A1, A2, A3, W0, W1, PW) do { MF; sacc += A0; sacc += A1; sacc += A2; sacc += A3; PIN(sacc); W0; W1; PIN(PW); SBAR(); } while (0)
#define EX(v) __builtin_amdgcn_exp2f(v)
#define GAPB(j, X, B) do { o[(j) & 3] = MFMA32(PAF_SEL(j), VFR(j), o[(j) & 3]); X[B] = EX(X[B]); X[B + 1] = EX(X[B + 1]); PIN(X); SBAR(); } while (0)
#define PAF_SEL(j) (((j) >> 2) == 0 ? PAF(0) : ((j) >> 2) == 1 ? PAF(1) : ((j) >> 2) == 2 ? PAF(2) : PAF(3))
#define STEP(C0, C1, P0, P1, t, GK, GV, GL, MASKREL) do { SBAR(); \
    const lptr vp_ = vp0 + sl_prev; \
    VRD(0); SBAR(); float sacc = (P0[0] + P0[1]); \
    GAPA(C0 = MFMA32(kf[0], qr[0], z16), P0[2], P0[3], P0[4], P0[5],     pw0[0] = PKW(P0, 0), pw0[1] = PKW(P0, 2), pw0); \
    VRD(1); SBAR(); GAPA(C1 = MFMA32(kf[1], qr[0], z16), P0[6], P0[7], P0[8], P0[9],     pw0[2] = PKW(P0, 4), pw0[3] = PKW(P0, 6), pw0); \
    VRD(2); SBAR(); GAPA(C0 = MFMA32(kf[2], qr[1], C0),  P0[10], P0[11], P0[12], P0[13], pw1[0] = PKW(P0, 8), pw1[1] = PKW(P0, 10), pw1); \
    GAPA(C1 = MFMA32(kf[3], qr[1], C1),  P0[14], P0[15], P1[0], P1[1],   pw1[2] = PKW(P0, 12), pw1[3] = PKW(P0, 14), pw1); \
    GAPA(C0 = MFMA32(kf[4], qr[2], C0),  P1[2], P1[3], P1[4], P1[5],     pw2[0] = PKW(P1, 0), pw2[1] = PKW(P1, 2), pw2); \
    GAPA(C1 = MFMA32(kf[5], qr[2], C1),  P1[6], P1[7], P1[8], P1[9],     pw2[2] = PKW(P1, 4), pw2[3] = PKW(P1, 6), pw2); \
    GAPA(C0 = MFMA32(kf[6], qr[3], C0),  P1[10], P1[11], P1[12], P1[13], pw3[0] = PKW(P1, 8), pw3[1] = PKW(P1, 10), pw3); \
    GAPA(C1 = MFMA32(kf[7], qr[3], C1),  P1[14], P1[15], 0.f, 0.f,       pw3[2] = PKW(P1, 12), pw3[3] = PKW(P1, 14), pw3); \
    l_reg += sacc; \
    if (GK) { DMA_K((t) + 3, sl_cur); } if (GV) { DMA_V((t) + 1, sl_next); } \
    if ((MASKREL) >= 0) cmask(C0, C1, (MASKREL), qrel, hi); \
    SBAR(); \
    const lptr kn_ = kp0 + sl_next; \
    VRD(3);  SBAR(); GAPB(0, C0, 0); \
    VRD(4);  SBAR(); GAPB(1, C0, 2); \
    VRD(5);  SBAR(); GAPB(2, C0, 4); \
    VRD(6);  SBAR(); GAPB(3, C0, 6); \
    VRD(7);  SBAR(); GAPB(4, C0, 8); \
    VRD(8);  SBAR(); GAPB(5, C0, 10); \
    VRD(9);  SBAR(); GAPB(6, C0, 12); \
    VRD(10); SBAR(); GAPB(7, C0, 14); \
    VRD(11); if (GL) { KLD(0, kn_); } SBAR(); GAPB(8, C1, 0); \
    VRD(12); if (GL) { KLD(1, kn_); } SBAR(); GAPB(9, C1, 2); \
    VRD(13); if (GL) { KLD(2, kn_); } SBAR(); GAPB(10, C1, 4); \
    VRD(14); if (GL) { KLD(3, kn_); } SBAR(); GAPB(11, C1, 6); \
    VRD(15); if (GL) { KLD(4, kn_); } SBAR(); GAPB(12, C1, 8); \
    if (GL) { KLD(5, kn_); } SBAR(); GAPB(13, C1, 10); \
    if (GL) { KLD(6, kn_); } SBAR(); GAPB(14, C1, 12); \
    if (GL) { KLD(7, kn_); } SBAR(); GAPB(15, C1, 14); \
    } while (0)
#define ENDW(tt) do { if ((tt) + 3 < NT) { WAIT_BAR(4); } else if ((tt) + 2 < NT) { WAIT_BAR(2); } else { WAIT_BAR(0); } } while (0)
    int t = 1;
    for (; t + 5 < NT; t += 2) {
        STEP(pB0, pB1, pA0, pA1, t, true, true, true, -1);     WAIT_BAR(4); ROT();
        STEP(pA0, pA1, pB0, pB1, t + 1, true, true, true, -1); WAIT_BAR(4); ROT();
    }
    unsigned c3v = 16u; if (u == 0 && c3 != nullptr && tid == 0) c3v = xb_ld(c3);
    for (; t + 1 < NT; t += 2) {
        STEP(pB0, pB1, pA0, pA1, t, (t + 3 < NT), (t + 1 < NT), (t + 1 < NT), (t - (NT - 2)));             ENDW(t);     ROT();
        STEP(pA0, pA1, pB0, pB1, t + 1, (t + 4 < NT), (t + 2 < NT), (t + 2 < NT), (t + 1 - (NT - 2)));     ENDW(t + 1); ROT();
    }
    STEP(pB0, pB1, pA0, pA1, NT - 1, false, false, false, 1);
    {   float sacc = 0.f;
#pragma unroll
        for (int r = 0; r < 16; ++r) sacc += pB0[r] + pB1[r];
        l_reg += sacc;
        pw0 = (u32x4){PKW(pB0, 0), PKW(pB0, 2), PKW(pB0, 4), PKW(pB0, 6)}; pw1 = (u32x4){PKW(pB0, 8), PKW(pB0, 10), PKW(pB0, 12), PKW(pB0, 14)};
        pw2 = (u32x4){PKW(pB1, 0), PKW(pB1, 2), PKW(pB1, 4), PKW(pB1, 6)}; pw3 = (u32x4){PKW(pB1, 8), PKW(pB1, 10), PKW(pB1, 12), PKW(pB1, 14)};
        const lptr vq = vp0 + sl_cur;
#pragma unroll
        for (int db = 0; db < 4; ++db) {
            { const s16x4 a = vtr(vq + (db * 4 + 0) * 1024), c = vtr(vq + (db * 4 + 0) * 1024 + 512); o[db] = MFMA32(PAF(0), ((bf16x8){a[0], a[1], a[2], a[3], c[0], c[1], c[2], c[3]}), o[db]); }
            { const s16x4 a = vtr(vq + (db * 4 + 1) * 1024), c = vtr(vq + (db * 4 + 1) * 1024 + 512); o[db] = MFMA32(PAF(1), ((bf16x8){a[0], a[1], a[2], a[3], c[0], c[1], c[2], c[3]}), o[db]); }
            { const s16x4 a = vtr(vq + (db * 4 + 2) * 1024), c = vtr(vq + (db * 4 + 2) * 1024 + 512); o[db] = MFMA32(PAF(2), ((bf16x8){a[0], a[1], a[2], a[3], c[0], c[1], c[2], c[3]}), o[db]); }
            { const s16x4 a = vtr(vq + (db * 4 + 3) * 1024), c = vtr(vq + (db * 4 + 3) * 1024 + 512); o[db] = MFMA32(PAF(3), ((bf16x8){a[0], a[1], a[2], a[3], c[0], c[1], c[2], c[3]}), o[db]); }
        }
    }
    if (u == 0 && c3 != nullptr && tid == 0) { if (c3v < 16u) XB_SPIN(xb_ld(c3) < 16u, tmo); __builtin_amdgcn_fence(__ATOMIC_ACQUIRE, "agent"); asm volatile("s_waitcnt vmcnt(0)" ::: "memory"); }
    LBAR();
    if (u == 0) ISSUE(qbB, qn);
    const int erow = 16 * wid + (lane >> 2), eqd = lane & 3; const size_t grow = rowbase + q0 + erow;
    bf16x8 zz[4]; f32x4 sw0[4], sw1[4];
    { const bf16_t* zp = SZB + grow * 512 + 128 * h + 32 * eqd; const float* sw = subw + 32 * eqd;
#pragma unroll
      for (int i = 0; i < 4; ++i) { zz[i] = __builtin_nontemporal_load((const bf16x8*)(zp + 8 * i)); sw0[i] = *(const f32x4*)(sw + 8 * i); sw1[i] = *(const f32x4*)(sw + 8 * i + 4); } }
    l_reg += __shfl_xor(l_reg, 32);
    ALAS float* wsf = (ALAS float*)(lds + WSF_OFF) + wid * 64;
    if (hi == 0) wsf[r32] = l_reg;
    float rli[16];
#pragma unroll
    for (int r = 0; r < 16; ++r) rli[r] = __builtin_amdgcn_rcpf(wsf[crow(r, hi)]);
    ALAS float* X = (ALAS float*)(lds + XOFF);
    if (sh == 1) {
#pragma unroll
        for (int db = 0; db < 4; ++db)
#pragma unroll
            for (int r = 0; r < 16; ++r) X[(32 * g + crow(r, hi)) * XROW + 32 * db + r32] = lam * o[db][r] * rli[r];
    }
    LBAR();
    if (sh == 0) {
#pragma unroll
        for (int db = 0; db < 4; ++db)
#pragma unroll
            for (int r = 0; r < 16; ++r) { ALAS float* xp = X + (32 * g + crow(r, hi)) * XROW + 32 * db + r32; *xp = o[db][r] * rli[r] - *xp; }
    }
    LBAR();
    {   const ALAS float* xs = X + erow * XROW + 32 * eqd;
        f32x4 v[8]; float ss = 0.f;
#pragma unroll
        for (int i = 0; i < 8; ++i) { v[i] = *(const ALAS f32x4*)(xs + 4 * i); ss += (v[i][0] * v[i][0] + v[i][1] * v[i][1]) + (v[i][2] * v[i][2] + v[i][3] * v[i][3]); }
        ss += __shfl_xor(ss, 1); ss += __shfl_xor(ss, 2);
        const float rstd = __builtin_amdgcn_rsqf(ss * (1.0f / 128.0f) + 1e-5f) * 0.8f;
        bf16_t* op = MIXED + grow * 1024 + 512 + 128 * h + 32 * eqd;
#pragma unroll
        for (int i = 0; i < 4; ++i) { float y[8];
#pragma unroll
            for (int e = 0; e < 4; ++e) { y[e] = v[2 * i][e] * rstd * sw0[i][e] * bf2f((unsigned short)zz[i][e]); y[4 + e] = v[2 * i + 1][e] * rstd * sw1[i][e] * bf2f((unsigned short)zz[i][4 + e]); }
            u32x4 pk; pk.x = cvtpk(y[0], y[1]); pk.y = cvtpk(y[2], y[3]); pk.z = cvtpk(y[4], y[5]); pk.w = cvtpk(y[6], y[7]);
            *(u32x4*)(op + 8 * i) = pk; }
    }
#pragma unroll
    for (int d0 = 0; d0 < 4; ++d0) qr[d0] = qn[d0];
    }
    __builtin_amdgcn_s_setprio(0);
    LBAR();
#undef ISSUE
#undef DMA_K
#undef DMA_V
#undef ROT
#undef KLD
#undef PKW
#undef PAF
#undef VRD
#undef VFR
#undef GAPA
#undef GAPB
#undef EX
#undef STEP
#undef ENDW
#undef PAF_SEL
}
#undef SBAR
#undef PIN
#undef MFMA32
#undef WAIT_BAR
}
constexpr int NWAVES = 8;
constexpr int RING_OFF = 0, RING_BYTES = 131072;
constexpr int LDS_BYTES = 147456;
constexpr int MISC_OFF = LDS_BYTES - 512;
static_assert(att::ATT_LDS_END <= MISC_OFF && att2::ATT2_LDS_END <= MISC_OFF, "attention LDS map");
constexpr int CW_PNL = 2048;
constexpr int CW_RND = 1024;
constexpr int CW_BAR = 4096;
constexpr int NPHASE = 5;
#ifndef G1_ALIGN
#define G1_ALIGN true
#endif
#ifndef G1_SP2
#define G1_SP2 true
#endif
#ifndef G2_ALIGN
#define G2_ALIGN true
#endif
#ifndef G2_SP2
#define G2_SP2 true
#endif

__device__ __forceinline__ float wave_sum(float v) {
#pragma unroll
    for (int o = 1; o < 64; o <<= 1) v += __shfl_xor(v, o);
    return v;
}
__device__ __forceinline__ int virt_row(int n0) {
    if (n0 < 512) { const int hA = n0 >> 7; return 256 * (hA < 2 ? hA : 6 + hA) + (n0 & 127); }
    if (n0 < 1024) return 1024 + (n0 - 512);
    if (n0 < 1536) { const int c = n0 - 1024, hA = c >> 7; return 256 * (hA < 2 ? hA : 6 + hA) + 128 + (c & 127); }
    if (n0 < 2560) { const int isk = n0 >= 2048, c = n0 - (isk ? 2048 : 1536), head = c >> 6, bj = (c >> 5) & 1;
        return 256 * ((isk ? 6 : 2) + (head >> 2)) + 128 * bj + 32 * (head & 3); }
    return n0;
}
__device__ __forceinline__ void p0_transpose_item(const float* W, int K, int N, bf16* WT, bool virt, LAS float* scr, int item, int lane) {
    const int nblk = N / 32, kb = item / nblk, nb = item % nblk, k0 = 64 * kb, n0 = 32 * nb;
#pragma unroll
    for (int i = 0; i < 32; ++i) { const int kk = 2 * i + (lane >> 5); scr[kk * 33 + (lane & 31)] = __builtin_nontemporal_load(W + (size_t)(k0 + kk) * N + n0 + (lane & 31)); }
    LDS_WAIT(); asm volatile("" ::: "memory");
    const int c = lane & 7; const int vr0 = virt ? virt_row(n0) : n0;
#pragma unroll
    for (int j = 0; j < 4; ++j) { const int n = (lane >> 3) + 8 * j; const LAS float* s = scr + (8 * c) * 33 + n;
        v4u o; o.x = pk2(s[0 * 33], s[1 * 33]); o.y = pk2(s[2 * 33], s[3 * 33]); o.z = pk2(s[4 * 33], s[5 * 33]); o.w = pk2(s[6 * 33], s[7 * 33]);
        *(GAS v4u*)(WT + (size_t)(vr0 + n) * K + k0 + 8 * c) = o; }
    LDS_WAIT(); asm volatile("" ::: "memory");
}

struct Args { const void* in[18]; float* out; unsigned char* ws; int ph_lo, ph_hi, li, pad; };
__global__ void __launch_bounds__(NWAVES * 64, 2) mk_fwd(Args args) {
    extern __shared__ __attribute__((aligned(16))) unsigned char lds_raw[];
    LAS unsigned char* lds = (LAS unsigned char*)lds_raw;
    const int tid = threadIdx.x, lane = tid & 63, wave = __builtin_amdgcn_readfirstlane(tid >> 6);
    const int G = gridDim.x, bx = blockIdx.x; const int vcu = (G % 8 == 0) ? (bx % 8) * (G / 8) + bx / 8 : bx;
    volatile LAS unsigned* MISC = (volatile LAS unsigned*)(lds + MISC_OFF);
    for (int u = tid; u < (LDS_BYTES - MISC_OFF) / 4; u += NWAVES * 64) MISC[u] = 0u;
    __syncthreads();
    unsigned char* ws = args.ws;
    gu32* ctl = (gu32*)(ws + WS_CTL);
    const float* x = (const float*)args.in[0]; const float* cc = (const float*)args.in[1]; const int* pos = (const int*)args.in[2];
    const float* norm_w = (const float*)args.in[3]; const float* w_ada = (const float*)args.in[4]; const float* b_ada = (const float*)args.in[5];
    const float* w_in = (const float*)args.in[6]; const float* sgw = (const float*)args.in[7]; const float* w_s = (const float*)args.in[8]; const float* b_s = (const float*)args.in[9];
    const float* qnw = (const float*)args.in[10]; const float* knw = (const float*)args.in[11];
    const float* subw = (const float*)args.in[16]; const float* w_out = (const float*)args.in[17];
    bf16* WIN = (bf16*)(ws + WS_WIN); bf16* WOUT = (bf16*)(ws + WS_WOUT); bf16* WSB = (bf16*)(ws + WS_WSB);
    float* MOD = (float*)(ws + WS_MOD); float* LAMP = (float*)(ws + WS_LAM); float* MODP = (float*)(ws + WS_MODP); float* SSQ = (float*)(ws + WS_SSQ);
    bf16* H = (bf16*)(ws + WS_H); bf16* MIXED = (bf16*)(ws + WS_MIXED); bf16* GB = (bf16*)(ws + WS_G); bf16* VA = (bf16*)(ws + WS_VA);
    bf16* QB = (bf16*)(ws + WS_Q); bf16* KB = (bf16*)(ws + WS_K); bf16* VB = (bf16*)(ws + WS_VB); bf16* SZB = (bf16*)(ws + WS_SZB);
    const int lo = args.ph_lo, hi = args.ph_hi;
    XcdBarrier bar; bar.bar = (unsigned*)(ctl + CW_BAR) + args.li * XCD_BAR_WORDS; bar.x = 0; bar.st = nullptr; bar.tot = (unsigned)G;
    if (hi - lo > 1) bar = xcd_barrier_post((unsigned*)(ctl + CW_BAR) + args.li * XCD_BAR_WORDS, MISC + 8, (unsigned)G);
    const bool grp = (G % 8 == 0);
    XcdBarrier barg = bar;
    if (hi - lo > 1 && grp) barg = xcd_barrier_post((unsigned*)(ctl + CW_BAR) + (8 + args.li * 8 + (bx & 7)) * XCD_BAR_WORDS, MISC + 10, (unsigned)(G / 8));
#define IN(k) (lo <= (k) && (k) < hi)
#ifdef MK_TPROBE
#define STAMP(k) do { if (tid == 0) { const unsigned long long t_ = __builtin_amdgcn_s_memrealtime(); MISC[32 + 2 * (k)] = (unsigned)t_; MISC[33 + 2 * (k)] = (unsigned)(t_ >> 32); } } while (0)
#else
#define STAMP(k) do { } while (0)
#endif
    STAMP(0);
#ifndef MK_REP
#define MK_REP (-1)
#endif
#define REPS(k) ((MK_REP == (k)) ? 2 : 1)
#define ENDPH(k) do { if (BOTH(k) || rep + 1 < REPS(k)) { if ((k) == 0 && grp) xcd_barrier<false, true>(bar, &barg); else if ((k) == 0 || !grp) xcd_barrier<false>(bar); else xcd_barrier<false>(barg); } } while (0)
#define BOTH(k) (IN(k) && IN((k) + 1))

    f32x4 xv[8][4]; bool xpre = false;
    if (IN(0)) _Pragma("unroll 1") for (int rep = 0; rep < REPS(0); ++rep) {
        LAS float* scr = (LAS float*)(lds + RING_OFF + wave * 16384);
        const int gw = vcu * NWAVES + wave, NGW = G * NWAVES;
        constexpr int I_MOD = 16 * 48, I_WIN = 16 * (NIN / 32), I_WOUT = 16 * 32, I_WS = 64;
        for (int r = gw; r < I_MOD; r += NGW) {
            {   const int ks = r / 48, k0 = 64 * ks, j0 = 64 * (r % 48);
#pragma unroll
                for (int b = 0; b < 8; ++b) { const float v = cc[b * 1024 + k0 + lane]; scr[b * 64 + lane] = v * __builtin_amdgcn_rcpf(1.f + __expf(-v)); }
                LDS_WAIT(); asm volatile("" ::: "memory");
                float acc[8];
#pragma unroll
                for (int b = 0; b < 8; ++b) acc[b] = 0.f;
#pragma unroll 1
                for (int kh = 0; kh < 2; ++kh) {
                    float wv[32];
#pragma unroll
                    for (int k = 0; k < 32; ++k) wv[k] = __builtin_nontemporal_load(w_ada + (size_t)(k0 + 32 * kh + k) * 3072 + j0 + lane);
#pragma unroll
                    for (int kc = 0; kc < 4; ++kc) {
#pragma unroll
                        for (int b = 0; b < 8; ++b) { const f32x4 c0 = *(const LAS f32x4*)(scr + b * 64 + 32 * kh + 8 * kc), c1 = *(const LAS f32x4*)(scr + b * 64 + 32 * kh + 8 * kc + 4);
                            acc[b] += (c0.x * wv[8 * kc] + c0.y * wv[8 * kc + 1]) + (c0.z * wv[8 * kc + 2] + c0.w * wv[8 * kc + 3]) + (c1.x * wv[8 * kc + 4] + c1.y * wv[8 * kc + 5]) + (c1.z * wv[8 * kc + 6] + c1.w * wv[8 * kc + 7]); }
                        asm volatile("" ::: "memory"); } }
                const float bias = (ks == 0) ? b_ada[j0 + lane] : 0.f;
#pragma unroll
                for (int b = 0; b < 8; ++b) MODP[(size_t)(ks * 8 + b) * 3072 + j0 + lane] = acc[b] + bias;
                LDS_WAIT(); asm volatile("" ::: "memory"); }
        }
        asm volatile("" ::: "memory");
        const bool spl = NGW > I_MOD + 512; const int gw2 = spl ? gw - I_MOD : (gw + NGW - (I_MOD % NGW)) % NGW, st2 = spl ? NGW - I_MOD : NGW;
        for (int it = (gw2 < 0 ? I_WIN + I_WOUT + I_WS : gw2); it < I_WIN + I_WOUT + I_WS; it += st2) {
            int r = it;
            if (r < I_WIN) { p0_transpose_item(w_in, 1024, NIN, WIN, true, scr, r, lane); continue; } r -= I_WIN;
            if (r < I_WOUT) { p0_transpose_item(w_out, 1024, 1024, WOUT, false, scr, r, lane); continue; } r -= I_WOUT;
            {   const int idx = r * 1024 + lane * 16, t = (idx >> 7) & 127, s0 = idx & 127; const float* src = w_s + idx;
                v4u o0, o1; float v[16];
#pragma unroll
                for (int e = 0; e < 16; ++e) v[e] = (s0 + e <= t) ? src[e] : 0.f;
                o0.x = pk2(v[0], v[1]); o0.y = pk2(v[2], v[3]); o0.z = pk2(v[4], v[5]); o0.w = pk2(v[6], v[7]);
                o1.x = pk2(v[8], v[9]); o1.y = pk2(v[10], v[11]); o1.z = pk2(v[12], v[13]); o1.w = pk2(v[14], v[15]);
                *(GAS v4u*)(WSB + idx) = o0; *(GAS v4u*)(WSB + idx + 8) = o1; }
        }
        if (bx == 0 && wave == 0) {
            const float* lq1 = (const float*)args.in[12]; const float* lk1 = (const float*)args.in[13]; const float* lq2 = (const float*)args.in[14]; const float* lk2 = (const float*)args.in[15];
            const float a = wave_sum(lq1[lane] * lk1[lane]), b2 = wave_sum(lq2[lane] * lk2[lane]);
            if (lane == 0) LAMP[0] = __expf(a) - __expf(b2) + 0.2f;
        }
        ENDPH(0);
        STAMP(1);
    }
    if (IN(1)) _Pragma("unroll 1") for (int rep = 0; rep < REPS(1); ++rep) {
        LAS float* g1s = (LAS float*)(lds + RING_OFF); LAS float* shs = g1s + 1024;
        const bool pcen = (G == 256) && grp && BOTH(0) && BOTH(1);
        for (int blk = vcu; blk < 256; blk += G) {
            const int b = blk >> 5;
            if (!(xpre && blk == vcu && wave != 0)) {
#pragma unroll
                for (int i = 0; i < 8; ++i) { const GAS f32x4* xr = (const GAS f32x4*)(x + ((size_t)blk * 64 + wave * 8 + i) * 1024) + lane;
#pragma unroll
                    for (int j = 0; j < 4; ++j) xv[i][j] = __builtin_nontemporal_load(xr + 64 * j); }
            }
            for (int k = tid; k < 1024; k += NWAVES * 64) { float sc = 0.f, sf = 0.f;
#pragma unroll
                for (int ks = 0; ks < 16; ++ks) { sf += MODP[(size_t)(ks * 8 + b) * 3072 + k]; sc += MODP[(size_t)(ks * 8 + b) * 3072 + 1024 + k]; }
                g1s[k] = norm_w[k] * (1.f + sc); shs[k] = sf; }
            if (tid < 96) { const int j = 96 * (blk & 31) + tid; float s = 0.f;
#pragma unroll
                for (int ks = 0; ks < 16; ++ks) s += MODP[(size_t)(ks * 8 + b) * 3072 + j];
                MOD[b * 3072 + j] = s; }
            __syncthreads();
            f32x4 gg[4], ss[4];
#pragma unroll
            for (int j = 0; j < 4; ++j) { gg[j] = *(const LAS f32x4*)(g1s + 4 * lane + 256 * j); ss[j] = *(const LAS f32x4*)(shs + 4 * lane + 256 * j); }
#pragma unroll
            for (int i = 0; i < 8; ++i) { const size_t row = (size_t)blk * 64 + wave * 8 + i; float s = 0.f;
#pragma unroll
                for (int j = 0; j < 4; ++j) s += (xv[i][j].x * xv[i][j].x + xv[i][j].y * xv[i][j].y) + (xv[i][j].z * xv[i][j].z + xv[i][j].w * xv[i][j].w);
                const float rstd = __builtin_amdgcn_rsqf(wave_sum(s) * (1.f / 1024.f) + 1e-6f);
                GAS unsigned long long* o8 = (GAS unsigned long long*)(H + row * 1024) + lane;
#pragma unroll
                for (int j = 0; j < 4; ++j) { const f32x4 hv = xv[i][j] * rstd * gg[j] + ss[j];
                    o8[64 * j] = (unsigned long long)pk2(hv.x, hv.y) | ((unsigned long long)pk2(hv.z, hv.w) << 32); }
            }
            __syncthreads();
        }
        bool pseam = false;
        if (pcen) {
            asm volatile("s_waitcnt vmcnt(0)" ::: "memory");
            __syncthreads();
            pseam = (MISC[11] == 1u);
        }
        if (pseam) {
            unsigned* pc = (unsigned*)(ctl + CW_PNL) + (bx & 7) * 256;
            if (tid == 0) { (void)xb_add(pc + (bx >> 5) * 32, 1u);
                xb_poll<false>(pc + ((bx >> 3) & 7) * 32, 4u, bar.bar);
                __builtin_amdgcn_fence(__ATOMIC_ACQUIRE, "agent"); asm volatile("s_waitcnt vmcnt(0)" ::: "memory"); }
            __syncthreads();
        } else ENDPH(1);
        STAMP(2);
    }
    if (IN(2)) _Pragma("unroll 1") for (int rep = 0; rep < REPS(2); ++rep) {
        const bool early = (G == 256) && grp && BOTH(1) && BOTH(2) && MISC[11] == 1u;
        unsigned* rcnt = (unsigned*)(ctl + CW_RND) + (bx & 7) * 128;
        pg8::Gemm g{H, WIN, MROWS, NIN, 1024}; pg8::Order1s S; S.init(MROWS, NIN, G, bx); S.cnt = rcnt; S.on = early;
        pg8::Epi1 E{GB, VA, QB, KB, VB, SZB, SSQ, pos, qnw, knw};
        pg8::gemm_phase<pg8::Epi1, pg8::Order1s, G1_ALIGN, G1_SP2, true>(lds + RING_OFF, g, S, E);
#define CWAIT(done) do { if (tid == 0) { XB_SPIN(!(done), bar.bar); __builtin_amdgcn_fence(__ATOMIC_ACQUIRE, "agent"); asm volatile("s_waitcnt vmcnt(0)" ::: "memory"); } __syncthreads(); } while (0)
        if (early) {
            if (bx >= 128) {
                if (tid == 0) (void)xb_add(rcnt + 64, 1u);
                CWAIT(xb_ld(rcnt) >= 32u && xb_ld(rcnt + 64) >= 32u);
                { const int j = (bx - 128) >> 3; att::gmlp_head4(lds, 64 * (bx & 7) + 16 * (j >> 2) + (j & 3), WSB, VA, SSQ, sgw, b_s, GB, MIXED); }
            } else {
                if (tid == 0) (void)xb_add(rcnt + 32, 1u);
                if (tid == 0) { xb_poll<false>(rcnt + 64, 32u, bar.bar); __builtin_amdgcn_fence(__ATOMIC_ACQUIRE, "agent"); asm volatile("s_waitcnt vmcnt(0)" ::: "memory"); }
                __syncthreads();
            }
        }
        if (!early) ENDPH(2);
        STAMP(3);
    }
    if (IN(3)) _Pragma("unroll 1") for (int rep = 0; rep < REPS(3); ++rep) {
        const float lam = LAMP[0]; const unsigned lds0 = (unsigned)(uintptr_t)lds_raw;
        for (int v = vcu; v < 256; v += G) {
            const int bh = v >> 3, s = v & 7; const bool e3 = (G == 256) && grp && BOTH(1) && BOTH(2) && MISC[11] == 1u;
#ifndef MK_REP_ATTN
#define MK_REP_ATTN 1
#endif
#ifndef MK_REP_GMLP
#define MK_REP_GMLP 1
#endif
#pragma unroll 1
            for (int i = 0; i < MK_REP_ATTN; ++i) { att2::attn_pair(lds, lds0, bh >> 2, bh & 3, 15 - s, s, QB, KB, VB, SZB, MIXED, subw, lam, e3 ? (unsigned*)(ctl + CW_RND) + (bx & 7) * 128 + 32 : nullptr, bar.bar); STAMP(9); }
            const bool early3 = (G == 256) && grp && BOTH(1) && BOTH(2) && MISC[11] == 1u;
            if (!early3) _Pragma("unroll 1") for (int ii = 0; ii < MK_REP_GMLP; ++ii) att::gmlp_pair(lds, 2 * v, 2 * v + 1, WSB, VA, SSQ, sgw, b_s, GB, MIXED);
            STAMP(10);
        }
        ENDPH(3);
        STAMP(4);
    }
    if (IN(4)) _Pragma("unroll 1") for (int rep = 0; rep < REPS(4); ++rep) {
        pg8::Gemm g{MIXED, WOUT, MROWS, 1024, 1024}; pg8::StaticOrder S; S.init(MROWS, 1024, G, bx);
        pg8::Epi2 E{x, MOD, args.out};
#if defined(MK_PROBE4) && MK_PROBE4 == 1
        { pg8::EpiNull EN; pg8::gemm_phase<pg8::EpiNull, pg8::StaticOrder, false, true>(lds + RING_OFF, g, S, EN); }
        pg8::gemm_phase<pg8::Epi2, pg8::StaticOrder, false, true>(lds + RING_OFF, g, S, E);
#elif defined(MK_PROBE4) && MK_PROBE4 == 2
        { pg8::Epi2x2 E2{E}; pg8::gemm_phase<pg8::Epi2x2, pg8::StaticOrder, false, true>(lds + RING_OFF, g, S, E2); }
#else
        pg8::gemm_phase<pg8::Epi2, pg8::StaticOrder, G2_ALIGN, G2_SP2, true>(lds + RING_OFF, g, S, E);
#endif
        ENDPH(4);
        STAMP(5);
#ifdef MK_TPROBE
        if (bx == MK_TBLK && tid == 0) {
            const unsigned long long ta = ((unsigned long long)MISC[33 + 2 * (MK_TA)] << 32) | MISC[32 + 2 * (MK_TA)], tb = ((unsigned long long)MISC[33 + 2 * (MK_TB)] << 32) | MISC[32 + 2 * (MK_TB)];
            const unsigned long long dt = (tb - ta) * MK_TMULT, t0_ = __builtin_amdgcn_s_memrealtime();
            while (__builtin_amdgcn_s_memrealtime() - t0_ < dt) __builtin_amdgcn_s_sleep(8);
        }
#endif
    }
#undef IN
#undef BOTH
}
#ifndef MK_N_LAUNCHES
#define MK_N_LAUNCHES 1
#endif
extern "C" void kernel_launch(void* const* d_in, const int* in_sizes, int n_in, void* d_out, int out_size, void* d_ws, size_t ws_size, hipStream_t stream) {
    static int grid = 0;
    if (grid == 0) {
        if (n_in != 18 || out_size != MROWS * DMODEL || ws_size < WS_END) { fprintf(stderr, "kernel_launch: unexpected sizes (n_in %d out %d ws %zu)\n", n_in, out_size, ws_size); grid = -1; return; }
        int dev = 0, cus = 0, per_cu = 0;
        if (hipGetDevice(&dev) != hipSuccess || hipDeviceGetAttribute(&cus, hipDeviceAttributeMultiprocessorCount, dev) != hipSuccess) { grid = -1; return; }
        if (hipFuncSetAttribute((const void*)mk_fwd, hipFuncAttributeMaxDynamicSharedMemorySize, LDS_BYTES) != hipSuccess) { fprintf(stderr, "kernel_launch: hipFuncSetAttribute failed\n"); grid = -1; return; }
        if (hipOccupancyMaxActiveBlocksPerMultiprocessor(&per_cu, (const void*)mk_fwd, NWAVES * 64, LDS_BYTES) != hipSuccess || per_cu < 1) { fprintf(stderr, "kernel_launch: occupancy query says %d blocks per CU\n", per_cu); }
        (void)hipGetLastError();
        grid = cus;
    }
    if (grid < 0) return;
    unsigned char* wsb = (unsigned char*)d_ws + ((ws_size - WS_END) & ~(size_t)(MiB - 1));
    (void)hipMemsetAsync(wsb + WS_CTL, 0, CTL_ZERO_BYTES, stream);
    Args a{};
    for (int i = 0; i < 18; ++i) a.in[i] = d_in[i];
    a.out = (float*)d_out; a.ws = wsb;
#if MK_N_LAUNCHES == 1
    a.ph_lo = 0; a.ph_hi = NPHASE; a.li = 0;
    hipLaunchKernelGGL(mk_fwd, dim3(grid), dim3(NWAVES * 64), LDS_BYTES, stream, a);
#else
#ifndef MK_REPL
#define MK_REPL (-1)
#endif
    for (int p = 0; p < NPHASE; ++p) { a.ph_lo = p; a.ph_hi = p + 1; a.li = p; hipLaunchKernelGGL(mk_fwd, dim3(grid), dim3(NWAVES * 64), LDS_BYTES, stream, a);
        if (p == MK_REPL) hipLaunchKernelGGL(mk_fwd, dim3(grid), dim3(NWAVES * 64), LDS_BYTES, stream, a); }
#endif
}
```
